# Optimizing an MI355X kernel written in HIP

```python
import jax, jax.numpy as jnp
from jax import lax
import numpy as np

D_MODEL = 1024
BATCH = 4
SEQ = 4096
DEPTH = 1

HEAD_DIM = 64
N_HEADS_SB = 8
N_HEADS_DSA = 8
N_HEADS_IDX = 8
D_IDX = 64
TOPK_MAX = 256
D_FF = 2816
Q_BLOCK = 128
N_MOD = 9
RMS_EPS = 1e-6

W_SB = N_HEADS_SB * HEAD_DIM
W_DSA = N_HEADS_DSA * HEAD_DIM
IN_SIZES = (W_SB, W_SB, W_SB,
            W_DSA, HEAD_DIM, HEAD_DIM,
            N_HEADS_IDX * D_IDX, D_IDX,
            N_HEADS_IDX)
D_IN = int(sum(IN_SIZES))
SPLIT_POINTS = tuple(int(v) for v in np.cumsum(IN_SIZES)[:-1])

kernel_name = "hybrid_stickbreaking_dsa_macaron_block"


def rmsnorm(x, g):
    xf = x.astype(jnp.float32)
    y = xf * lax.rsqrt(jnp.mean(xf * xf, axis=-1, keepdims=True) + RMS_EPS)
    return (y * g.astype(jnp.float32)).astype(x.dtype)


def modulate(x, shift, scale):
    return x * (1.0 + scale[:, None, :]) + shift[:, None, :]


def swiglu(x, w1, w3, w2):
    return (jax.nn.silu(x @ w1) * (x @ w3)) @ w2


def to_blocks(a):
    b, s = a.shape[:2]
    return a.reshape((b, s // Q_BLOCK, Q_BLOCK) + a.shape[2:]).swapaxes(0, 1)


def from_blocks(a):
    a = a.swapaxes(0, 1)
    return a.reshape((a.shape[0], a.shape[1] * a.shape[2]) + a.shape[3:])


def stick_breaking_attention(q, k, v):
    S, dh = q.shape[1], q.shape[-1]
    scale = dh ** -0.5
    kpos = jnp.arange(S)
    nb = S // Q_BLOCK

    def block(args):
        q_blk, i = args
        qpos = i * Q_BLOCK + jnp.arange(Q_BLOCK)
        z = jnp.einsum('bqhd,bshd->bhqs', q_blk, k).astype(jnp.float32) * scale
        strict = (kpos[None, :] < qpos[:, None])[None, None]
        log1m = jnp.where(strict, jax.nn.log_sigmoid(-z), 0.0)
        after = lax.cumsum(log1m, axis=3, reverse=True) - log1m
        a = jnp.where(strict, jnp.exp(jax.nn.log_sigmoid(z) + after), 0.0)
        return jnp.einsum('bhqs,bshd->bqhd', a.astype(v.dtype), v)

    out = lax.map(block, (to_blocks(q), jnp.arange(nb)))
    return from_blocks(out)


def dsa_attention(q, k, v, q_idx, k_idx, w_idx):
    B, S, H, dh = q.shape
    topk = min(TOPK_MAX, S // 4)
    scale = dh ** -0.5
    idx_scale = (D_IDX ** -0.5) * (N_HEADS_IDX ** -0.5)
    slopes = jnp.exp2(-8.0 * jnp.arange(1, H + 1, dtype=jnp.float32) / H)
    kpos = jnp.arange(S)
    bidx = jnp.arange(B)[:, None, None]
    nb = S // Q_BLOCK

    def block(args):
        q_blk, qi_blk, wi_blk, i = args
        qpos = i * Q_BLOCK + jnp.arange(Q_BLOCK)
        causal = (kpos[None, :] <= qpos[:, None])[None]
        rel = jax.nn.relu(jnp.einsum('bqhd,bsd->bqhs', qi_blk, k_idx).astype(jnp.float32))
        score = jnp.einsum('bqhs,bqh->bqs', rel, wi_blk.astype(jnp.float32)) * idx_scale
        score = jnp.where(causal, score, -jnp.inf)
        top_val, sel = lax.top_k(score, topk)
        valid = top_val > -jnp.inf
        k_sel = k[bidx, sel]
        v_sel = v[bidx, sel]
        logits = jnp.einsum('bqhd,bqkd->bhqk', q_blk, k_sel).astype(jnp.float32) * scale
        dist = (qpos[None, :, None] - sel).astype(jnp.float32)
        logits = logits - slopes[None, :, None, None] * dist[:, None]
        logits = jnp.where(valid[:, None], logits, -jnp.inf)
        p = jax.nn.softmax(logits, axis=-1)
        return jnp.einsum('bhqk,bqkd->bqhd', p.astype(v.dtype), v_sel)

    out = lax.map(block, (to_blocks(q), to_blocks(q_idx), to_blocks(w_idx), jnp.arange(nb)))
    return from_blocks(out)


def setup_inputs(seed: int = 0) -> dict:
    key = jax.random.key(seed)
    ks = jax.random.split(key, 24)
    f32 = jnp.float32

    def dense(k, shape, fan_in, mult=1.0):
        return jax.random.normal(k, shape, f32) * (mult * fan_in ** -0.5)

    def gain(k, shape):
        return 1.0 + 0.05 * jax.random.normal(k, shape, f32)

    L, D = DEPTH, D_MODEL
    return {
        "x": jax.random.normal(ks[0], (BATCH, SEQ, D), f32),
        "c": jax.random.normal(ks[1], (BATCH, D), f32),
        "w_ada": dense(ks[2], (L, D, N_MOD * D), D, 0.5),
        "b_ada": 0.02 * jax.random.normal(ks[3], (L, N_MOD * D), f32),
        "g_ffn1": gain(ks[4], (L, D)),
        "w1_ffn1": dense(ks[5], (L, D, D_FF), D),
        "w3_ffn1": dense(ks[6], (L, D, D_FF), D),
        "w2_ffn1": dense(ks[7], (L, D_FF, D), D_FF),
        "g_mix": gain(ks[8], (L, D)),
        "w_in": dense(ks[9], (L, D, D_IN), D),
        "g_q_dsa": gain(ks[10], (L, HEAD_DIM)),
        "g_k_dsa": gain(ks[11], (L, HEAD_DIM)),
        "w_proj_sb": dense(ks[12], (L, W_SB, D), W_SB),
        "w_proj_dsa": dense(ks[13], (L, W_DSA, D), W_DSA),
        "w_gate": dense(ks[14], (L, D, 2 * D), D),
        "b_gate": 0.02 * jax.random.normal(ks[15], (L, 2 * D), f32),
        "w_out": dense(ks[16], (L, D, D), D),
        "g_ffn2": gain(ks[17], (L, D)),
        "w1_ffn2": dense(ks[18], (L, D, D_FF), D),
        "w3_ffn2": dense(ks[19], (L, D, D_FF), D),
        "w2_ffn2": dense(ks[20], (L, D_FF, D), D_FF),
    }


def reference(x, c, w_ada, b_ada, g_ffn1, w1_ffn1, w3_ffn1, w2_ffn1, g_mix, w_in,
              g_q_dsa, g_k_dsa, w_proj_sb, w_proj_dsa, w_gate, b_gate, w_out,
              g_ffn2, w1_ffn2, w3_ffn2, w2_ffn2):
    B, S, D = x.shape
    sc = jax.nn.silu(c)
    h = x
    for l in range(DEPTH):
        mod = sc @ w_ada[l] + b_ada[l]
        sh1, sc1, gt1, sh2, sc2, gt2, sh3, sc3, gt3 = jnp.split(mod, N_MOD, axis=-1)

        n1 = modulate(rmsnorm(h, g_ffn1[l]), sh1, sc1)
        h = h + 0.5 * gt1[:, None, :] * swiglu(n1, w1_ffn1[l], w3_ffn1[l], w2_ffn1[l])

        n = modulate(rmsnorm(h, g_mix[l]), sh2, sc2)
        proj = n @ w_in[l]
        q_sb, k_sb, v_sb, q_d, k_d, v_d, q_i, k_i, w_i = jnp.split(proj, SPLIT_POINTS, axis=-1)

        heads = lambda t, nh: t.reshape(B, S, nh, -1)
        y_sb = stick_breaking_attention(heads(q_sb, N_HEADS_SB), heads(k_sb, N_HEADS_SB),
                                        heads(v_sb, N_HEADS_SB))
        q_d = rmsnorm(heads(q_d, N_HEADS_DSA), g_q_dsa[l])
        k_d = rmsnorm(k_d, g_k_dsa[l])
        y_d = dsa_attention(q_d, k_d, v_d, heads(q_i, N_HEADS_IDX), k_i, w_i)

        y_sb = y_sb.reshape(B, S, W_SB) @ w_proj_sb[l]
        y_d = y_d.reshape(B, S, W_DSA) @ w_proj_dsa[l]
        gates = jax.nn.sigmoid(n @ w_gate[l] + b_gate[l])
        g_sb, g_d = jnp.split(gates, 2, axis=-1)
        mixed = (g_sb * y_sb + g_d * y_d) @ w_out[l]
        h = h + gt2[:, None, :] * mixed

        n3 = modulate(rmsnorm(h, g_ffn2[l]), sh3, sc3)
        h = h + 0.5 * gt3[:, None, :] * swiglu(n3, w1_ffn2[l], w3_ffn2[l], w2_ffn2[l])
    return h
```

```cpp
#include <hip/hip_runtime.h>
#include <cstdio>
#include <cstdint>
#include <cmath>
namespace pg8 {
#define PG8_LAS __attribute__((address_space(3)))
typedef unsigned short bf16_t;
typedef short bf16x8 __attribute__((ext_vector_type(8)));
typedef float f32x4 __attribute__((ext_vector_type(4)));
typedef unsigned u32x4 __attribute__((ext_vector_type(4)));
constexpr int BM = 256, BK = 64, HALF = 128, HTB = HALF * BK * 2  , STAGE_BYTES = 8 * HTB, NXCD = 8, WGM = 8;

__host__ __device__ __forceinline__ int lds_byte(int r, int c) { const int st = (r >> 4) * 2 + (c >> 5), rr = r & 15, cc = c & 31, ob = rr * 64 + cc * 2; return st * 1024 + (ob ^ (((ob >> 9) & 1) << 5)); }
__host__ __device__ __forceinline__ void stage_rc(int b, int& R, int& C) { const int st = b / 1024, sb = b % 1024, swz = sb ^ (((sb >> 9) & 1) << 5); R = (st >> 1) * 16 + swz / 64; C = (st & 1) * 32 + (swz % 64) / 2; }
__host__ __device__ __forceinline__ int perm32(int rho) { const int n = rho >> 4, i = rho & 15; return 8 * (i >> 2) + 4 * n + (i & 3); }

struct Unit { int pm, pn; };
struct Gemm { const bf16_t* A; const bf16_t* Bt; int M, N, K; };

struct StaticOrder {
    int nM, nN, nwg, G, c;
    __host__ __device__ void init(int M, int N, int G_, int c_) { nM = M / BM; nN = N / BM; nwg = nM * nN; G = G_; c = c_; }
    __host__ __device__ bool next(int i, Unit& u) const {
        const long L = (long)i * G + c; if (L >= nwg) return false;
        int wgid = (int)L; { const int q = nwg / NXCD, r = nwg % NXCD, xcd = wgid % NXCD, off = wgid / NXCD; wgid = (xcd < r ? xcd * (q + 1) : r * (q + 1) + (xcd - r) * q) + off; }
        const int nig = WGM * nN, gid = wgid / nig, fm = gid * WGM, gsz = (nM - fm) < WGM ? (nM - fm) : WGM;
        u.pm = fm + ((wgid % nig) % gsz); u.pn = (wgid % nig) / gsz; return true;
    }
    __device__ __forceinline__ void a_ready(const Unit&) const {}
    __device__ __forceinline__ void done(const Unit&) const {}
};
__device__ __forceinline__ unsigned cvt_pk_bf16(float lo, float hi) { unsigned r; asm volatile("v_cvt_pk_bf16_f32 %0, %1, %2" : "=v"(r) : "v"(lo), "v"(hi)); return r; }
typedef float f32x2 __attribute__((ext_vector_type(2)));
typedef unsigned u32x2 __attribute__((ext_vector_type(2)));
__device__ __forceinline__ float sigm(float x) { return __builtin_amdgcn_rcpf(1.0f + __builtin_amdgcn_exp2f(-1.4426950408889634f * x)); }
__device__ __forceinline__ float bf_lo(unsigned w) { return __uint_as_float(w << 16); }
__device__ __forceinline__ float bf_hi(unsigned w) { return __uint_as_float(w & 0xffff0000u); }
struct EpiSwiglu {
    static constexpr bool PERM = true, AFTER_DRAIN = false;
    bf16_t* O; int ldc;
    __device__ __forceinline__ void operator()(const f32x4 (&acc)[2][2][4][2], const Unit& u, int wr, int wc, int fr, int fq) const {
        const int row0 = u.pm * BM + wr * 64 + fr, col0 = u.pn * HALF + wc * 32 + 8 * fq;
#pragma unroll
        for (int ai = 0; ai < 2; ++ai)
#pragma unroll
            for (int m = 0; m < 4; ++m) { bf16_t* rowp = O + (size_t)(row0 + ai * HALF + m * 16) * ldc + col0;
                const f32x4 g0 = acc[ai][0][m][0], g1 = acc[ai][0][m][1], u0 = acc[ai][1][m][0], u1 = acc[ai][1][m][1];
                f32x4 h0, h1;
#pragma unroll
                for (int e = 0; e < 4; ++e) { h0[e] = g0[e] * sigm(g0[e]) * u0[e]; h1[e] = g1[e] * sigm(g1[e]) * u1[e]; }
                u32x4 w; w.x = cvt_pk_bf16(h0[0], h0[1]); w.y = cvt_pk_bf16(h0[2], h0[3]); w.z = cvt_pk_bf16(h1[0], h1[1]); w.w = cvt_pk_bf16(h1[2], h1[3]);
                *(u32x4*)rowp = w; }
    }
};
struct EpiPlain {
    static constexpr bool PERM = true, AFTER_DRAIN = false;
    bf16_t* O; int ldc;
    __device__ __forceinline__ void operator()(const f32x4 (&acc)[2][2][4][2], const Unit& u, int wr, int wc, int fr, int fq) const {
        const int row0 = u.pm * BM + wr * 64 + fr, col0 = u.pn * BM + wc * 32 + 8 * fq;
#pragma unroll
        for (int ai = 0; ai < 2; ++ai)
#pragma unroll
            for (int m = 0; m < 4; ++m) { bf16_t* rowp = O + (size_t)(row0 + ai * HALF + m * 16) * ldc + col0;
#pragma unroll
                for (int bj = 0; bj < 2; ++bj) { const f32x4 v0 = acc[ai][bj][m][0], v1 = acc[ai][bj][m][1];
                    u32x4 w; w.x = cvt_pk_bf16(v0[0], v0[1]); w.y = cvt_pk_bf16(v0[2], v0[3]); w.z = cvt_pk_bf16(v1[0], v1[1]); w.w = cvt_pk_bf16(v1[2], v1[3]);
                    *(u32x4*)(rowp + bj * HALF) = w; } }
    }
};
struct EpiProjB {
    static constexpr bool PERM = true, AFTER_DRAIN = false;
    bf16_t* P; bf16_t* G; const float* bias;
    __device__ __forceinline__ void operator()(const f32x4 (&acc)[2][2][4][2], const Unit& u, int wr, int wc, int fr, int fq) const {
        const bool isg = u.pn >= 8;
        const int row0 = u.pm * BM + wr * 64 + fr, col0 = (isg ? u.pn - 8 : u.pn) * BM + wc * 32 + 8 * fq;
        bf16_t* base = isg ? G : P;
        f32x4 bv[2][2];
#pragma unroll
        for (int bj = 0; bj < 2; ++bj)
#pragma unroll
            for (int n = 0; n < 2; ++n) bv[bj][n] = isg ? *(const f32x4*)(bias + col0 + bj * HALF + 4 * n) : (f32x4){0.f, 0.f, 0.f, 0.f};
#pragma unroll
        for (int ai = 0; ai < 2; ++ai)
#pragma unroll
            for (int m = 0; m < 4; ++m) { bf16_t* rowp = base + (size_t)(row0 + ai * HALF + m * 16) * 2048 + col0;
#pragma unroll
                for (int bj = 0; bj < 2; ++bj) { f32x4 v0 = acc[ai][bj][m][0] + bv[bj][0], v1 = acc[ai][bj][m][1] + bv[bj][1];
                    if (isg) {
#pragma unroll
                        for (int e = 0; e < 4; ++e) { v0[e] = sigm(v0[e]); v1[e] = sigm(v1[e]); } }
                    u32x4 w; w.x = cvt_pk_bf16(v0[0], v0[1]); w.y = cvt_pk_bf16(v0[2], v0[3]); w.z = cvt_pk_bf16(v1[0], v1[1]); w.w = cvt_pk_bf16(v1[2], v1[3]);
                    *(u32x4*)(rowp + bj * HALF) = w; } }
    }
};
struct EpiResid {
    static constexpr bool PERM = false, AFTER_DRAIN = false;
    const float* base; float* out; const float* mod; int chunk; float coef;
    __device__ __forceinline__ void operator()(const f32x4 (&acc)[2][2][4][2], const Unit& u, int wr, int wc, int fr, int fq) const {
        const int row0 = u.pm * BM + wr * 64 + fr, col0 = u.pn * BM + wc * 32 + 4 * fq;
        const float* mg = mod + (size_t)(u.pm >> 4) * 9216 + chunk * 1024 + col0;
        f32x4 gv[2][2];
#pragma unroll
        for (int bj = 0; bj < 2; ++bj)
#pragma unroll
            for (int n = 0; n < 2; ++n) gv[bj][n] = *(const f32x4*)(mg + bj * HALF + n * 16) * coef;
#pragma unroll
        for (int ai = 0; ai < 2; ++ai)
#pragma unroll
            for (int m = 0; m < 4; ++m) { const size_t off = (size_t)(row0 + ai * HALF + m * 16) * 1024 + col0;
#pragma unroll
                for (int bj = 0; bj < 2; ++bj)
#pragma unroll
                    for (int n = 0; n < 2; ++n) { const f32x4 bs = *(const f32x4*)(base + off + bj * HALF + n * 16);
                        *(f32x4*)(out + off + bj * HALF + n * 16) = bs + gv[bj][n] * acc[ai][bj][m][n]; }
                if (m & 1) asm volatile("" ::: "memory"); }
    }
};
struct EpiGate1 {
    static constexpr bool PERM = false, AFTER_DRAIN = false;
    const bf16_t* G; float* TMP;
    __device__ __forceinline__ void operator()(const f32x4 (&acc)[2][2][4][2], const Unit& u, int wr, int wc, int fr, int fq) const {
        const int row0 = u.pm * BM + wr * 64 + fr, col0 = u.pn * BM + wc * 32 + 4 * fq;
#pragma unroll
        for (int ai = 0; ai < 2; ++ai)
#pragma unroll
            for (int m = 0; m < 4; ++m) { const size_t r = (size_t)(row0 + ai * HALF + m * 16);
#pragma unroll
                for (int bj = 0; bj < 2; ++bj)
#pragma unroll
                    for (int n = 0; n < 2; ++n) { const int c = col0 + bj * HALF + n * 16; const u32x2 g = *(const u32x2*)(G + r * 2048 + c);
                        const f32x4 a = acc[ai][bj][m][n]; f32x4 o; o[0] = bf_lo(g.x) * a[0]; o[1] = bf_hi(g.x) * a[1]; o[2] = bf_lo(g.y) * a[2]; o[3] = bf_hi(g.y) * a[3];
                        *(f32x4*)(TMP + r * 1024 + c) = o; }
                if (m & 1) asm volatile("" ::: "memory"); }
    }
};
struct EpiGate2 {
    static constexpr bool PERM = true, AFTER_DRAIN = false;
    const bf16_t* G; const float* TMP; bf16_t* MG;
    __device__ __forceinline__ void operator()(const f32x4 (&acc)[2][2][4][2], const Unit& u, int wr, int wc, int fr, int fq) const {
        const int row0 = u.pm * BM + wr * 64 + fr, col0 = u.pn * BM + wc * 32 + 8 * fq;
#pragma unroll
        for (int ai = 0; ai < 2; ++ai)
#pragma unroll
            for (int m = 0; m < 4; ++m) { const size_t r = (size_t)(row0 + ai * HALF + m * 16);
#pragma unroll
                for (int bj = 0; bj < 2; ++bj) { const int c = col0 + bj * HALF;
                    const u32x4 g = *(const u32x4*)(G + r * 2048 + 1024 + c); const f32x4 t0 = *(const f32x4*)(TMP + r * 1024 + c), t1 = *(const f32x4*)(TMP + r * 1024 + c + 4);
                    const f32x4 a0 = acc[ai][bj][m][0], a1 = acc[ai][bj][m][1];
                    u32x4 w; w.x = cvt_pk_bf16(t0[0] + bf_lo(g.x) * a0[0], t0[1] + bf_hi(g.x) * a0[1]); w.y = cvt_pk_bf16(t0[2] + bf_lo(g.y) * a0[2], t0[3] + bf_hi(g.y) * a0[3]);
                    w.z = cvt_pk_bf16(t1[0] + bf_lo(g.z) * a1[0], t1[1] + bf_hi(g.z) * a1[1]); w.w = cvt_pk_bf16(t1[2] + bf_lo(g.w) * a1[2], t1[3] + bf_hi(g.w) * a1[3]);
                    *(u32x4*)(MG + r * 1024 + c) = w; }
                if (m & 1) asm volatile("" ::: "memory"); }
    }
};
template <class Epi, class Sched, bool ALIGN_EPI = false, bool SP2 = false>
__device__ __forceinline__ void gemm_phase(PG8_LAS unsigned char* lds, const Gemm g, const Sched& S, const Epi& E) {
    const int tid = threadIdx.x, wid = __builtin_amdgcn_readfirstlane(tid >> 6), lane = tid & 63, wr = wid >> 2, wc = wid & 3, fr = lane & 15, fq = lane >> 4;
    const int K = g.K, nt = K / BK;
    unsigned voffA[2], voffB[2];
#pragma unroll
    for (int i = 0; i < 2; ++i) { int R, C; stage_rc(tid * 16 + i * 8192, R, C); const int Rb = Epi::PERM ? ((R & ~31) + perm32(R & 31)) : R;
        voffA[i] = (unsigned)(R * K + C) * 2u; voffB[i] = (unsigned)(Rb * K + C) * 2u; }
    const size_t kstep = (size_t)(BK * 2);
    const size_t hstep = (size_t)HALF * K * 2;
    const size_t tstep = 2 * hstep;
    const unsigned ldsw = (unsigned)wid * 1024u;
    const int aoff = lds_byte(wr * 64 + fr, fq * 8), boff = lds_byte(wc * 32 + fr, fq * 8);
#define PG8_SA(b, h) (((b) * 2 + (h)) * HTB)
#define PG8_SB(b, h) ((4 + (b) * 2 + (h)) * HTB)
#define PG8_STAGE(bufoff, gbase, voff) do { _Pragma("unroll") for (int _i = 0; _i < 2; ++_i) \
        __builtin_amdgcn_global_load_lds((const unsigned*)((const char*)(gbase) + (voff)[_i]), (PG8_LAS unsigned*)(lds + (bufoff) + ldsw + _i * 8192), 16, 0, 0); } while (0)
#define PG8_LDA(dst, b, h) do { _Pragma("unroll") for (int m = 0; m < 4; ++m) _Pragma("unroll") for (int k = 0; k < 2; ++k) dst[m][k] = *(const PG8_LAS bf16x8*)(lds + PG8_SA(b, h) + aoff + m * 2048 + k * 1024); } while (0)
#define PG8_LDB(dst, b, h) do { _Pragma("unroll") for (int n = 0; n < 2; ++n) _Pragma("unroll") for (int k = 0; k < 2; ++k) dst[n][k] = *(const PG8_LAS bf16x8*)(lds + PG8_SB(b, h) + boff + n * 2048 + k * 1024); } while (0)
#define PG8_MMA(ai, bj, At, Bt) do { __builtin_amdgcn_s_setprio(1); _Pragma("unroll") for (int m = 0; m < 4; ++m) _Pragma("unroll") for (int n = 0; n < 2; ++n) _Pragma("unroll") for (int k = 0; k < 2; ++k) \
        acc[ai][bj][m][n] = __builtin_amdgcn_mfma_f32_16x16x32_bf16(Bt[n][k], At[m][k], acc[ai][bj][m][n], 0, 0, 0); __builtin_amdgcn_s_setprio(0); } while (0)
#define PG8_WAIT_V(n) asm volatile("s_waitcnt vmcnt(" #n ")" ::: "memory")
#define PG8_WAIT_L(n) asm volatile("s_waitcnt lgkmcnt(" #n ")" ::: "memory")
#define PG8_BAR __builtin_amdgcn_s_barrier()
#define PG8_SCHED __builtin_amdgcn_sched_barrier(0)
    Unit cur, nxt; int ui = 0;
    if (!S.next(0, cur)) return;
    f32x4 acc[2][2][4][2];
#pragma unroll
    for (int a = 0; a < 2; ++a)
#pragma unroll
        for (int b = 0; b < 2; ++b)
#pragma unroll
            for (int m = 0; m < 4; ++m)
#pragma unroll
                for (int n = 0; n < 2; ++n) acc[a][b][m][n] = (f32x4){0.f, 0.f, 0.f, 0.f};
    bf16x8 At[4][2], B0[2][2], B1[2][2];
    const char* cA = (const char*)g.A + (size_t)cur.pm * tstep; const char* cB = (const char*)g.Bt + (size_t)cur.pn * tstep;
    S.a_ready(cur);
    if constexpr (SP2) {
        PG8_STAGE(PG8_SB(0, 0), cB, voffB); PG8_STAGE(PG8_SB(0, 1), cB + hstep, voffB); PG8_STAGE(PG8_SA(0, 0), cA, voffA); PG8_STAGE(PG8_SA(0, 1), cA + hstep, voffA);
        if (wr == 1) PG8_BAR;
        PG8_WAIT_V(2); PG8_BAR;
        PG8_STAGE(PG8_SB(1, 0), cB + kstep, voffB); PG8_STAGE(PG8_SA(1, 0), cA + kstep, voffA); PG8_STAGE(PG8_SB(1, 1), cB + hstep + kstep, voffB);
        PG8_WAIT_V(6); PG8_BAR;
    } else {
        PG8_STAGE(PG8_SB(0, 0), cB, voffB); PG8_STAGE(PG8_SA(0, 0), cA, voffA); PG8_STAGE(PG8_SB(0, 1), cB + hstep, voffB); PG8_STAGE(PG8_SA(0, 1), cA + hstep, voffA);
        if (wr == 1) PG8_BAR;
        PG8_WAIT_V(4); PG8_BAR;
        PG8_STAGE(PG8_SB(1, 0), cB + kstep, voffB); PG8_STAGE(PG8_SA(1, 0), cA + kstep, voffA); PG8_STAGE(PG8_SB(1, 1), cB + hstep + kstep, voffB);
        PG8_WAIT_V(6); PG8_BAR;
    }
    for (;;) {
        const bool has_next = S.next(ui + 1, nxt);
        const char* nA = has_next ? (const char*)g.A + (size_t)nxt.pm * tstep : cA; const char* nB = has_next ? (const char*)g.Bt + (size_t)nxt.pn * tstep : cB;
        for (int t = 0; t < nt; t += 2) {
            const bool last = (t == nt - 2);
            const char* a1 = cA + (size_t)(t + 1) * kstep;
            const char* a2 = last ? nA : cA + (size_t)(t + 2) * kstep; const char* b2 = last ? nB : cB + (size_t)(t + 2) * kstep;
            const char* a3 = a2 + kstep; const char* b3 = b2 + kstep;
            if (last && has_next) S.a_ready(nxt);
            if constexpr (SP2) {
            PG8_LDB(B0, 0, 0); PG8_LDB(B1, 0, 1); PG8_SCHED; PG8_LDA(At, 0, 0); PG8_STAGE(PG8_SA(1, 1), a1 + hstep, voffA);
            PG8_WAIT_V(8); PG8_WAIT_L(0); PG8_BAR; PG8_MMA(0, 0, At, B0); PG8_MMA(0, 1, At, B1); PG8_BAR; PG8_SCHED;
            PG8_LDA(At, 0, 1); PG8_STAGE(PG8_SB(0, 0), b2, voffB); PG8_STAGE(PG8_SB(0, 1), b2 + hstep, voffB); PG8_STAGE(PG8_SA(0, 0), a2, voffA);
            PG8_WAIT_V(8); PG8_WAIT_L(0); PG8_BAR; PG8_MMA(1, 0, At, B0); PG8_MMA(1, 1, At, B1); PG8_BAR; PG8_SCHED;
            PG8_LDB(B0, 1, 0); PG8_LDB(B1, 1, 1); PG8_SCHED; PG8_LDA(At, 1, 0); PG8_STAGE(PG8_SA(0, 1), a2 + hstep, voffA);
            PG8_WAIT_V(8); PG8_WAIT_L(0); PG8_BAR; PG8_MMA(0, 0, At, B0); PG8_MMA(0, 1, At, B1); PG8_BAR; PG8_SCHED;
            PG8_LDA(At, 1, 1); PG8_STAGE(PG8_SB(1, 0), b3, voffB); PG8_STAGE(PG8_SB(1, 1), b3 + hstep, voffB); PG8_STAGE(PG8_SA(1, 0), a3, voffA);
            PG8_WAIT_V(8); PG8_WAIT_L(0); PG8_BAR; PG8_MMA(1, 0, At, B0); PG8_MMA(1, 1, At, B1); PG8_BAR; PG8_SCHED;
            } else {
            PG8_LDB(B0, 0, 0); PG8_SCHED; PG8_LDA(At, 0, 0); PG8_STAGE(PG8_SA(1, 1), a1 + hstep, voffA);
            PG8_WAIT_L(8); PG8_BAR; PG8_WAIT_L(0); PG8_MMA(0, 0, At, B0); PG8_BAR; PG8_SCHED;
            PG8_LDB(B1, 0, 1); PG8_STAGE(PG8_SB(0, 0), b2, voffB);
            PG8_BAR; PG8_WAIT_L(0); PG8_MMA(0, 1, At, B1); PG8_BAR;
            PG8_LDA(At, 0, 1); PG8_STAGE(PG8_SA(0, 0), a2, voffA);
            PG8_BAR; PG8_WAIT_L(0); PG8_MMA(1, 0, At, B0); PG8_BAR; PG8_SCHED;
            PG8_STAGE(PG8_SB(0, 1), b2 + hstep, voffB);
            PG8_WAIT_V(6); PG8_BAR; PG8_MMA(1, 1, At, B1); PG8_BAR;
            PG8_LDB(B0, 1, 0); PG8_SCHED; PG8_LDA(At, 1, 0); PG8_STAGE(PG8_SA(0, 1), a2 + hstep, voffA);
            PG8_WAIT_L(8); PG8_BAR; PG8_WAIT_L(0); PG8_MMA(0, 0, At, B0); PG8_BAR; PG8_SCHED;
            PG8_LDB(B1, 1, 1); PG8_STAGE(PG8_SB(1, 0), b3, voffB);
            PG8_BAR; PG8_WAIT_L(0); PG8_MMA(0, 1, At, B1); PG8_BAR;
            PG8_LDA(At, 1, 1); PG8_STAGE(PG8_SA(1, 0), a3, voffA);
            PG8_BAR; PG8_WAIT_L(0); PG8_MMA(1, 0, At, B0); PG8_BAR; PG8_SCHED;
            PG8_STAGE(PG8_SB(1, 1), b3 + hstep, voffB);
            PG8_WAIT_V(6); PG8_BAR; PG8_MMA(1, 1, At, B1); PG8_BAR;
            }
        }
        if constexpr (ALIGN_EPI) { if (wr == 0) PG8_BAR; }
        if constexpr (!Epi::AFTER_DRAIN) { E(acc, cur, wr, wc, fr, fq); S.done(cur); }
        if (!has_next) break;
#pragma unroll
        for (int a = 0; a < 2; ++a)
#pragma unroll
            for (int b = 0; b < 2; ++b)
#pragma unroll
                for (int m = 0; m < 4; ++m)
#pragma unroll
                    for (int n = 0; n < 2; ++n) acc[a][b][m][n] = (f32x4){0.f, 0.f, 0.f, 0.f};
        cur = nxt; cA = nA; cB = nB; ++ui;
        if constexpr (ALIGN_EPI) { if (wr == 1) PG8_BAR; }
    }
    PG8_WAIT_V(0);
    if constexpr (!ALIGN_EPI) { if (wr == 0) PG8_BAR; }
    PG8_BAR;
    if constexpr (Epi::AFTER_DRAIN) { E.fused(acc, cur, wr, wc, fr, fq, lds, wid, lane); S.done(cur); }
#undef PG8_SA
#undef PG8_SB
#undef PG8_STAGE
#undef PG8_LDA
#undef PG8_LDB
#undef PG8_MMA
#undef PG8_WAIT_V
#undef PG8_WAIT_L
#undef PG8_BAR
#undef PG8_SCHED
}
}
constexpr int NWAVES = 8;
constexpr int BATCH = 4, SEQ = 4096, D = 1024, M = BATCH * SEQ, FF = 2816, DIN = 2760, NMOD = 9216;
constexpr int NA = 768, NB = 4096;
constexpr int IA_QI = 0, IA_KI = 512, IA_WI = 576, IA_KD = 640, IA_VD = 704;
constexpr int PB_QSB = 0, PB_KSB = 512, PB_VSB = 1024, PB_QD = 1536;
constexpr float RMS_EPS = 1e-6f;
constexpr size_t MiB = 1u << 20, HMiB = 1u << 19;
constexpr size_t WS_CTL = 0, CTL_ZERO_BYTES = 1 * MiB;
constexpr size_t WS_MOD = 1 * MiB;
constexpr size_t WS_W13_1 = 2 * MiB, WS_W2_1 = 13 * MiB, WS_W13_2 = 18 * MiB + HMiB, WS_W2_2 = 29 * MiB + HMiB;
constexpr size_t WS_WA = 35 * MiB, WS_WB = 36 * MiB + HMiB, WS_WPSB = 44 * MiB + HMiB, WS_WPD = 45 * MiB + HMiB, WS_WOUT = 46 * MiB + HMiB;
constexpr size_t WS_KDN = 48 * MiB + HMiB;
constexpr size_t WS_XN = 51 * MiB;
constexpr size_t WS_YSB = 51 * MiB, WS_YD = 67 * MiB;
constexpr size_t WS_IDXP = 83 * MiB;
constexpr size_t WS_SEL = 107 * MiB;
constexpr size_t WS_MG = 83 * MiB;
constexpr size_t WS_BIG = 115 * MiB;
constexpr size_t WS_HB = WS_BIG;
constexpr size_t WS_SCORES = WS_BIG;
constexpr size_t WS_P2 = WS_BIG, WS_GATES = WS_BIG + 64 * MiB;
constexpr size_t WS_TMP = WS_BIG;
constexpr size_t WS_END = 243 * MiB;
constexpr int CW_TMO = 0, CW_CODE = 1;
constexpr int CW_BAR = 4096;

constexpr int RING_OFF = 0, RING_BYTES = 131072;
constexpr int LDSCTL_OFF = RING_BYTES, MISC_OFF = LDSCTL_OFF + 320;
constexpr int LDS_BYTES = 147456;
#define GAS __attribute__((address_space(1)))
#define LAS __attribute__((address_space(3)))
typedef unsigned short bf16;
typedef unsigned v4u __attribute__((ext_vector_type(4)));
typedef float f32x4 __attribute__((ext_vector_type(4)));
typedef short bf16x8 __attribute__((ext_vector_type(8)));
typedef GAS unsigned gu32;
typedef GAS unsigned long long gu64;
#define RLX_AGENT __ATOMIC_RELAXED, __HIP_MEMORY_SCOPE_AGENT
#define LDS_WAIT() asm volatile("s_waitcnt lgkmcnt(0)" ::: "memory")
#define VM_WAIT() asm volatile("s_waitcnt vmcnt(0)" ::: "memory")
__device__ __forceinline__ unsigned long long rt() { return __builtin_amdgcn_s_memrealtime(); }
__device__ __forceinline__ unsigned f2bf(float f) { unsigned u = __builtin_bit_cast(unsigned, f); return (u + 0x7fffu + ((u >> 16) & 1u)) >> 16; }
__device__ __forceinline__ unsigned pk2(float lo, float hi) { return f2bf(lo) | (f2bf(hi) << 16); }
#define XB_TMO      128
#define XB_XCNT(j)  (256  + 64 * (j))
#define XB_XSUB(j)  (1280 + 64 * (j))
#define XB_XGEN(j)  (2304 + 64 * (j))
#define XB_TOP      3328
#define XB_TOPGEN   3392
#define XCD_BAR_WORDS 3456
#define XB_SPIN_CAP (1u << 18)

__device__ __forceinline__ unsigned xb_ld(unsigned* p)              { return __hip_atomic_load(p, __ATOMIC_RELAXED, __HIP_MEMORY_SCOPE_AGENT); }
__device__ __forceinline__ unsigned xb_add(unsigned* p, unsigned v) { return __hip_atomic_fetch_add(p, v, __ATOMIC_RELAXED, __HIP_MEMORY_SCOPE_AGENT); }
__device__ __forceinline__ unsigned xb_xcc_id() { return (unsigned)__builtin_amdgcn_s_getreg((3 << 11) | 20) & 0xFu; }
#define XB_SPIN(cond, bar) do { unsigned _sp = 0; while (cond) { __builtin_amdgcn_s_sleep(1); \
    if ((++_sp & 255u) == 0u) { if (xb_ld(&(bar)[XB_TMO])) break; if (_sp > XB_SPIN_CAP) { atomicAdd(&(bar)[XB_TMO], 1u); break; } } } } while (0)

struct XcdBarrier {
    unsigned* bar; unsigned x;
    volatile LAS unsigned* st;
};

__device__ __forceinline__ XcdBarrier xcd_barrier_post(unsigned* bar, volatile LAS unsigned* st) {
    XcdBarrier b; b.bar = bar; b.x = xb_xcc_id(); b.st = st;
    if (threadIdx.x == 0) (void)xb_add(&bar[XB_XCNT(b.x)], 1u);
    return b;
}
__device__ __forceinline__ void xcd_barrier_complete(unsigned* bar, unsigned x, unsigned& nloc, unsigned& nx) {
    const unsigned G = gridDim.x * gridDim.y * gridDim.z;
    unsigned sum, cnt, mine, sp = 0u;
    for (;;) {
        sum = 0u; cnt = 0u; mine = 0u;
#pragma unroll
        for (unsigned j = 0; j < 16; ++j) { const unsigned c = xb_ld(&bar[XB_XCNT(j)]); sum += c; cnt += (c > 0u) ? 1u : 0u; mine = (j == x) ? c : mine; }
        if (sum == G) break;
        __builtin_amdgcn_s_sleep(1);
        if ((++sp & 255u) == 0u) { if (xb_ld(&bar[XB_TMO])) break; if (sp > XB_SPIN_CAP) { atomicAdd(&bar[XB_TMO], 1u); break; } }
    }
    nloc = mine > 0u ? mine : 1u; nx = cnt > 0u ? cnt : 1u;
}

__device__ __forceinline__ void xcd_barrier(const XcdBarrier& b) {
    asm volatile("s_waitcnt vmcnt(0)" ::: "memory");
    __syncthreads();
    if (threadIdx.x == 0) {
        unsigned* bar = b.bar;
        __builtin_amdgcn_s_waitcnt(0);
        unsigned nloc = b.st[0], nx = b.st[1];
        if (nloc == 0u) { xcd_barrier_complete(bar, b.x, nloc, nx); b.st[0] = nloc; b.st[1] = nx; }
        const unsigned old = xb_add(&bar[XB_XSUB(b.x)], 1u);
        const unsigned gen = old / nloc;
        if (old + 1u == (gen + 1u) * nloc) {
            __builtin_amdgcn_fence(__ATOMIC_RELEASE, "agent");
            asm volatile("s_waitcnt vmcnt(0)" ::: "memory");
            const unsigned og = xb_add(&bar[XB_TOP], 1u);
            const unsigned tg = og / nx;
            if (og + 1u == (tg + 1u) * nx) xb_add(&bar[XB_TOPGEN], 1u);
            else XB_SPIN(xb_ld(&bar[XB_TOPGEN]) == tg, bar);
            __builtin_amdgcn_fence(__ATOMIC_ACQUIRE, "agent");
            xb_add(&bar[XB_XGEN(b.x)], 1u);
            asm volatile("s_waitcnt vmcnt(0)" ::: "memory");
        } else {
            XB_SPIN(xb_ld(&bar[XB_XGEN(b.x)]) == gen, bar);
            __builtin_amdgcn_fence(__ATOMIC_ACQUIRE, "agent");
            asm volatile("s_waitcnt vmcnt(0)" ::: "memory");
        }
    }
    __syncthreads();
}
namespace sba {
typedef short bf16x8 __attribute__((ext_vector_type(8)));
typedef short s16x4 __attribute__((ext_vector_type(4)));
typedef short v4i16_t __attribute__((ext_vector_type(4)));
typedef float f32x16 __attribute__((ext_vector_type(16)));
typedef unsigned u32x4 __attribute__((ext_vector_type(4)));
constexpr int KOFF = 0, VOFF = 16384, FLAG_OFF = 32768, OST_OFF = 33024, SB_LDS_BYTES = OST_OFF + 8 * 4096;
__device__ __forceinline__ int crow(int r, int hi) { return (r & 3) + 8 * (r >> 2) + 4 * hi; }
__device__ __forceinline__ unsigned cvtpk(float lo, float hi) { unsigned r; asm volatile("v_cvt_pk_bf16_f32 %0, %1, %2" : "=v"(r) : "v"(lo), "v"(hi)); return r; }
__device__ __forceinline__ s16x4 vtr(const LAS unsigned char* p) { return __builtin_bit_cast(s16x4, __builtin_amdgcn_ds_read_tr16_b64_v4i16((LAS v4i16_t*)p)); }

__device__ __forceinline__ void sb_unit(int b, int h, int qb, const bf16* P2, bf16* Y, LAS unsigned char* shm) {
    const int tid = threadIdx.x, lane = tid & 63, r32 = lane & 31, hi = lane >> 5; const int wid = __builtin_amdgcn_readfirstlane(tid >> 6);
    const size_t rowbase = (size_t)b * SEQ; const int q0 = qb * 256;
    const int tmin = q0 + 32 * wid, t = tmin + r32, tmax = tmin + 31;
    const bf16* Qw = P2 + (rowbase + tmin) * 2048 + PB_QSB + h * 64;
    const bf16* Kh = P2 + rowbase * 2048 + PB_KSB + h * 64; const bf16* Vh = P2 + rowbase * 2048 + PB_VSB + h * 64;
    const bf16* ksrc = Kh + (size_t)lane * 2048 + wid * 8;
    const bf16* vsrc = Vh + (size_t)(16 * (wid & 3) + (lane >> 2)) * 2048 + (wid >> 2) * 32 + (lane & 3) * 8;
    bf16x8 qr[4];
#pragma unroll
    for (int d0 = 0; d0 < 4; ++d0) qr[d0] = *(const bf16x8*)(Qw + (size_t)r32 * 2048 + d0 * 16 + hi * 8);
    volatile LAS unsigned* flags = (volatile LAS unsigned*)(shm + FLAG_OFF);
    float carry = 1.0f; f32x16 o[2]; o[0] = f32x16{}; o[1] = f32x16{};
    const int nt = 4 * qb + 4;
#define SB_STAGE(kt, buf) do { \
        __builtin_amdgcn_global_load_lds((const unsigned*)(ksrc + (size_t)(kt) * 64 * 2048), (LAS unsigned*)(shm + KOFF + (buf) * 8192 + wid * 1024), 16, 0, 0); \
        __builtin_amdgcn_global_load_lds((const unsigned*)(vsrc + (size_t)(kt) * 64 * 2048), (LAS unsigned*)(shm + VOFF + (buf) * 8192 + wid * 1024), 16, 0, 0); } while (0)
    SB_STAGE(nt - 1, 0);
    int it = 0;
    for (int kt = nt - 1; kt >= 0; --kt, ++it) {
        const int cur = it & 1;
        asm volatile("s_waitcnt vmcnt(0)" ::: "memory");
        __syncthreads();
        if (it > 0) { unsigned alld = 1u;
#pragma unroll
            for (int w = 0; w < 8; ++w) alld &= flags[((it - 1) & 1) * 8 + w];
            if (alld) break; }
        if (kt > 0) SB_STAGE(kt - 1, cur ^ 1);
        bool wdone = __builtin_amdgcn_ballot_w64(carry != 0.0f) == 0ull;
        if (64 * kt < tmax && !wdone) {
            const LAS unsigned char* kb = shm + KOFF + cur * 8192 + hi * 1024 + r32 * 16;
            f32x16 p0 = f32x16{}, p1 = f32x16{};
#pragma unroll
            for (int d0 = 0; d0 < 4; ++d0) { const bf16x8 k0 = *(const LAS bf16x8*)(kb + d0 * 2048), k1 = *(const LAS bf16x8*)(kb + d0 * 2048 + 512);
                p0 = __builtin_amdgcn_mfma_f32_32x32x16_bf16(k0, qr[d0], p0, 0, 0, 0); p1 = __builtin_amdgcn_mfma_f32_32x32x16_bf16(k1, qr[d0], p1, 0, 0, 0); }
            const float C = 0.125f * 1.4426950408889634f;
            f32x16 B0, B1;
#pragma unroll
            for (int r = 0; r < 16; ++r) {
                { const float zs = fminf(fmaxf(p0[r] * C, -100.f), 100.f), e = __builtin_amdgcn_exp2f(zs), rr = __builtin_amdgcn_rcpf(1.0f + e); B0[r] = e * rr; p0[r] = rr; }
                { const float zs = fminf(fmaxf(p1[r] * C, -100.f), 100.f), e = __builtin_amdgcn_exp2f(zs), rr = __builtin_amdgcn_rcpf(1.0f + e); B1[r] = e * rr; p1[r] = rr; } }
            if (64 * kt + 63 >= tmin) {
#pragma unroll
                for (int r = 0; r < 16; ++r) { const int key = 64 * kt + crow(r, hi);
                    if (key >= t) { p0[r] = 1.0f; B0[r] = 0.f; }
                    if (key + 32 >= t) { p1[r] = 1.0f; B1[r] = 0.f; } } }
            float s0[8], s1[8], s2[8], gp[8], isuf[9];
#pragma unroll
            for (int g = 0; g < 8; ++g) { const float x0 = g < 4 ? p0[4 * g] : p1[4 * (g - 4)], x1 = g < 4 ? p0[4 * g + 1] : p1[4 * (g - 4) + 1], x2 = g < 4 ? p0[4 * g + 2] : p1[4 * (g - 4) + 2], x3 = g < 4 ? p0[4 * g + 3] : p1[4 * (g - 4) + 3];
                s2[g] = x3; s1[g] = x3 * x2; s0[g] = s1[g] * x1; gp[g] = s0[g] * x0; }
            isuf[8] = 1.0f;
#pragma unroll
            for (int g = 7; g >= 0; --g) isuf[g] = gp[g] * isuf[g + 1];
            float tot;
            { const auto rr = __builtin_amdgcn_permlane32_swap(__float_as_uint(isuf[0]), __float_as_uint(isuf[0]), false, false); tot = __uint_as_float(rr[0]) * __uint_as_float(rr[1]); }
#pragma unroll
            for (int g = 0; g < 8; ++g) {
                const auto rr = __builtin_amdgcn_permlane32_swap(__float_as_uint(isuf[g]), __float_as_uint(isuf[g + 1]), false, false);
                const float pvv = hi ? __uint_as_float(rr[0]) : __uint_as_float(rr[1]);
                const float base = carry * isuf[g + 1] * pvv;
                if (g < 4) { p0[4 * g + 3] = B0[4 * g + 3] * base; p0[4 * g + 2] = B0[4 * g + 2] * (base * s2[g]); p0[4 * g + 1] = B0[4 * g + 1] * (base * s1[g]); p0[4 * g] = B0[4 * g] * (base * s0[g]); }
                else { const int q = 4 * (g - 4); p1[q + 3] = B1[q + 3] * base; p1[q + 2] = B1[q + 2] * (base * s2[g]); p1[q + 1] = B1[q + 1] * (base * s1[g]); p1[q] = B1[q] * (base * s0[g]); }
            }
            carry *= tot;
            u32x4 pw[4];
#pragma unroll
            for (int i = 0; i < 4; ++i) { pw[0][i] = cvtpk(p0[2 * i], p0[2 * i + 1]); pw[1][i] = cvtpk(p0[8 + 2 * i], p0[9 + 2 * i]); pw[2][i] = cvtpk(p1[2 * i], p1[2 * i + 1]); pw[3][i] = cvtpk(p1[8 + 2 * i], p1[9 + 2 * i]); }
            const LAS unsigned char* vp = shm + VOFF + cur * 8192 + ((lane >> 4) & 1) * 32 + (lane & 3) * 8 + (4 * hi + ((lane & 15) >> 2)) * 64;
#pragma unroll
            for (int d0 = 0; d0 < 2; ++d0)
#pragma unroll
                for (int ks = 0; ks < 4; ++ks) { const s16x4 lo = vtr(vp + d0 * 4096 + ks * 1024), hh = vtr(vp + d0 * 4096 + ks * 1024 + 512);
                    const bf16x8 vf = (bf16x8){lo[0], lo[1], lo[2], lo[3], hh[0], hh[1], hh[2], hh[3]};
                    o[d0] = __builtin_amdgcn_mfma_f32_32x32x16_bf16(__builtin_bit_cast(bf16x8, pw[ks]), vf, o[d0], 0, 0, 0); }
            wdone = __builtin_amdgcn_ballot_w64(carry != 0.0f) == 0ull;
        }
        if (lane == 0) flags[cur * 8 + wid] = wdone ? 1u : 0u;
    }
#undef SB_STAGE
    { LAS bf16* stg = (LAS bf16*)(shm + OST_OFF) + wid * 2048;
#pragma unroll
      for (int r = 0; r < 16; ++r) { const int orow = crow(r, hi);
#pragma unroll
          for (int d0 = 0; d0 < 2; ++d0) stg[orow * 64 + d0 * 32 + r32] = (bf16)f2bf(o[d0][r]); }
      asm volatile("s_waitcnt lgkmcnt(0)" ::: "memory");
      bf16* Ow = Y + (rowbase + tmin) * 512 + h * 64;
#pragma unroll
      for (int i = 0; i < 4; ++i) { const int row = i * 8 + (lane >> 3), ch = lane & 7; const u32x4 v = *(const LAS u32x4*)(stg + row * 64 + ch * 8); *(u32x4*)(Ow + (size_t)row * 512 + ch * 8) = v; } }
    asm volatile("s_waitcnt vmcnt(0) lgkmcnt(0)" ::: "memory");
    __syncthreads();
}
__device__ __forceinline__ void sb_phase(const bf16* P2, bf16* Y, LAS unsigned char* shm, int vcu, int G) {
    for (int u = vcu; u < BATCH * 8 * 16; u += G) sb_unit(u >> 7, (u >> 4) & 7, u & 15, P2, Y, shm);
}
}
namespace dsa {
typedef short bf16x8 __attribute__((ext_vector_type(8)));
typedef short s16x4 __attribute__((ext_vector_type(4)));
typedef short v4i16_t __attribute__((ext_vector_type(4)));
typedef float f32x16 __attribute__((ext_vector_type(16)));
typedef float f32x4 __attribute__((ext_vector_type(4)));
typedef unsigned u32x4 __attribute__((ext_vector_type(4)));
typedef unsigned u32x2 __attribute__((ext_vector_type(2)));
__device__ __forceinline__ int crow(int r, int hi) { return (r & 3) + 8 * (r >> 2) + 4 * hi; }
__device__ __forceinline__ unsigned cvtpk(float lo, float hi) { unsigned r; asm volatile("v_cvt_pk_bf16_f32 %0, %1, %2" : "=v"(r) : "v"(lo), "v"(hi)); return r; }
__device__ __forceinline__ float blo(unsigned w) { return __uint_as_float(w << 16); }
__device__ __forceinline__ float bhi(unsigned w) { return __uint_as_float(w & 0xffff0000u); }
__device__ __forceinline__ unsigned f2key(float f) { f = f + 0.0f; const unsigned u = __float_as_uint(f); return (u & 0x80000000u) ? ~u : (u | 0x80000000u); }
__device__ __forceinline__ int wsum_i(int v) {
#pragma unroll
    for (int o = 1; o < 64; o <<= 1) v += __shfl_xor(v, o);
    return v;
}
__device__ __forceinline__ void cnt_ge(int& c, unsigned k, unsigned cand) { asm volatile("v_cmp_ge_u32 vcc, %1, %2\n\tv_addc_co_u32 %0, vcc, 0, %0, vcc" : "+v"(c) : "v"(k), "v"(cand) : "vcc"); }
__device__ __forceinline__ int selflag(unsigned k, unsigned prefix, int idx, int Y) { int f; unsigned thr;
    asm volatile("v_cmp_ge_u32 vcc, %2, %3\n\tv_addc_co_u32 %1, vcc, 0, %4, vcc\n\tv_cmp_ge_u32 vcc, %5, %1\n\tv_cndmask_b32 %0, 0, 1, vcc" : "=v"(f), "=&v"(thr) : "v"(idx), "v"(Y), "v"(prefix), "v"(k) : "vcc"); return f; }
__device__ __forceinline__ unsigned mbcnt(unsigned long long m) { return __builtin_amdgcn_mbcnt_hi((unsigned)(m >> 32), __builtin_amdgcn_mbcnt_lo((unsigned)m, 0u)); }

constexpr int TQ_OFF = 0;
constexpr int TT_OFF = 32768, TT_ROW = 68, TT_WAVE = 32 * TT_ROW * 4;
constexpr int TS_OFF = TT_OFF + 8 * TT_WAVE, TS_WAVE = 640;
constexpr int TW_OFF = TS_OFF + 8 * TS_WAVE;
constexpr int TOPK_LDS_BYTES = TW_OFF + 1024;

__device__ __forceinline__ void topk_unit(int b, int j, const bf16* IDXP, float* scr, unsigned short* SEL, LAS unsigned char* shm) {
    const int tid = threadIdx.x, lane = tid & 63, r32 = lane & 31, hi = lane >> 5; const int wid = __builtin_amdgcn_readfirstlane(tid >> 6);
    const size_t rowbase = (size_t)b * SEQ; const int t0 = 32 * j;
#pragma unroll
    for (int k = 0; k < 4; ++k) { const int c = tid + 512 * k, row = c >> 6, c16 = c & 63;
        const u32x4 v = *(const u32x4*)(IDXP + (rowbase + t0 + row) * NA + IA_QI + c16 * 8);
        *(LAS u32x4*)(shm + TQ_OFF + (((c16 >> 3) * 8 + (c16 & 7)) * 32 + row) * 16) = v; }
    if (tid < 256) { const int q = tid >> 3, hh = tid & 7;
        ((LAS float*)(shm + TW_OFF))[hh * 32 + q] = blo((unsigned)IDXP[(rowbase + t0 + q) * NA + IA_WI + hh]); }
    __syncthreads();
    const int ntiles = (t0 + 32 + 63) >> 6;
    LAS float* tt = (LAS float*)(shm + TT_OFF + wid * TT_WAVE);
    for (int kt = wid; kt < ntiles; kt += 8) {
        bf16x8 kf[4][2];
        const bf16* kp = IDXP + (rowbase + 64 * kt + r32) * NA + IA_KI + 8 * hi;
#pragma unroll
        for (int d0 = 0; d0 < 4; ++d0) { kf[d0][0] = *(const bf16x8*)(kp + 16 * d0); kf[d0][1] = *(const bf16x8*)(kp + (size_t)32 * NA + 16 * d0); }
        f32x16 s0 = f32x16{}, s1 = f32x16{};
#pragma unroll 2
        for (int h = 0; h < 8; ++h) {
            const float wh = ((const LAS float*)(shm + TW_OFF))[h * 32 + r32];
            f32x16 p0 = f32x16{}, p1 = f32x16{};
#pragma unroll
            for (int d0 = 0; d0 < 4; ++d0) { const bf16x8 qf = *(const LAS bf16x8*)(shm + TQ_OFF + ((h * 8 + 2 * d0 + hi) * 32 + r32) * 16);
                p0 = __builtin_amdgcn_mfma_f32_32x32x16_bf16(kf[d0][0], qf, p0, 0, 0, 0); p1 = __builtin_amdgcn_mfma_f32_32x32x16_bf16(kf[d0][1], qf, p1, 0, 0, 0); }
#pragma unroll
            for (int r = 0; r < 16; ++r) { s0[r] += wh * fmaxf(p0[r], 0.f); s1[r] += wh * fmaxf(p1[r], 0.f); }
        }
#pragma unroll
        for (int g = 0; g < 4; ++g) {
            *(LAS f32x4*)(tt + r32 * TT_ROW + 8 * g + 4 * hi) = (f32x4){s0[4 * g], s0[4 * g + 1], s0[4 * g + 2], s0[4 * g + 3]};
            *(LAS f32x4*)(tt + r32 * TT_ROW + 32 + 8 * g + 4 * hi) = (f32x4){s1[4 * g], s1[4 * g + 1], s1[4 * g + 2], s1[4 * g + 3]}; }
        asm volatile("s_waitcnt lgkmcnt(0)" ::: "memory");
#pragma unroll
        for (int i = 0; i < 8; ++i) { const int row = 4 * i + (lane >> 4), col = (lane & 15) * 4;
            const f32x4 v = *(const LAS f32x4*)(tt + row * TT_ROW + col);
            *(f32x4*)(scr + (size_t)row * 4096 + 64 * kt + col) = v; }
        asm volatile("s_waitcnt lgkmcnt(0)" ::: "memory");
    }
    asm volatile("s_waitcnt vmcnt(0)" ::: "memory");
    __syncthreads();
    LAS unsigned short* sl = (LAS unsigned short*)(shm + TS_OFF + wid * TS_WAVE);
    for (int qi = wid; qi < 32; qi += 8) {
        const int t = t0 + qi, n = t + 1;
        unsigned short* selrow = SEL + (rowbase + t) * 256;
        if (n <= 256) { const unsigned a = 4 * lane; *(u32x2*)(selrow + a) = (u32x2){a | ((a + 1) << 16), (a + 2) | ((a + 3) << 16)}; continue; }
        unsigned k[64];
        const float* sr = scr + (size_t)qi * 4096;
#pragma unroll
        for (int i = 0; i < 16; ++i) {
            if (256 * i < n) { const f32x4 v = *(const f32x4*)(sr + 256 * i + 4 * lane);
#pragma unroll
                for (int e = 0; e < 4; ++e) k[4 * i + e] = (256 * i + 4 * lane + e < n) ? f2key(v[e]) : 0u; }
            else {
#pragma unroll
                for (int e = 0; e < 4; ++e) k[4 * i + e] = 0u; }
        }
        unsigned prefix = 0u;
        for (int bit = 31; bit >= 0; --bit) {
            const unsigned cand = prefix | (1u << bit); int c = 0;
#pragma unroll
            for (int i = 0; i < 64; ++i) cnt_ge(c, k[i], cand);
            if (wsum_i(c) >= 256) prefix = cand;
        }
        const int l4 = 4 * lane;
        int cg = 0, cge = 0;
#pragma unroll
        for (int i = 0; i < 64; ++i) { cnt_ge(cg, k[i], prefix + 1u); cnt_ge(cge, k[i], prefix); }
        const int ngt = wsum_i(cg), neq = wsum_i(cge) - ngt, need = 256 - ngt;
        int Y = 4096;
        if (neq != need) { Y = 0;
            for (int bit = 12; bit >= 0; --bit) { const int cand = Y | (1 << bit); int c = 0;
#pragma unroll
                for (int i = 0; i < 64; ++i) c += selflag(k[i], prefix, (256 * (i >> 2) + (i & 3)) | l4, cand);
                if (wsum_i(c) - ngt <= need) Y = cand; } }
        int cs = 0;
#pragma unroll
        for (int i = 0; i < 64; ++i) cs += selflag(k[i], prefix, (256 * (i >> 2) + (i & 3)) | l4, Y);
        int incl = cs;
#pragma unroll
        for (int o = 1; o < 64; o <<= 1) { const int v = __shfl_up(incl, o); if (lane >= o) incl += v; }
        int pos = incl - cs; const int dummy = 256 + lane;
#pragma unroll
        for (int i = 0; i < 64; ++i) { const int idx = (256 * (i >> 2) + (i & 3)) | l4; const int f = selflag(k[i], prefix, idx, Y);
            sl[dummy + f * (pos - dummy)] = (unsigned short)idx; pos += f; }
        asm volatile("s_waitcnt lgkmcnt(0)" ::: "memory");
        *(u32x2*)(selrow + 4 * lane) = *(const LAS u32x2*)(sl + 4 * lane);
        asm volatile("s_waitcnt lgkmcnt(0)" ::: "memory");
    }
    asm volatile("s_waitcnt vmcnt(0)" ::: "memory");
    __syncthreads();
}
__device__ __forceinline__ void kdn_rows(const bf16* IDXP, const float* gk, bf16* KDN, int row0, int nrows, int tid) {
    const int lane = tid & 63, wid = tid >> 6;
    for (int r = wid * 8 + (lane >> 3); r < nrows; r += 64) {
        const int row = row0 + r, ch = lane & 7;
        const u32x4 v = *(const u32x4*)(IDXP + (size_t)row * NA + IA_KD + 8 * ch);
        float x[8] = {blo(v.x), bhi(v.x), blo(v.y), bhi(v.y), blo(v.z), bhi(v.z), blo(v.w), bhi(v.w)};
        float ss = 0.f;
#pragma unroll
        for (int e = 0; e < 8; ++e) ss += x[e] * x[e];
        ss += __shfl_xor(ss, 1); ss += __shfl_xor(ss, 2); ss += __shfl_xor(ss, 4);
        const float inv = 1.0f / sqrtf(ss * (1.f / 64.f) + RMS_EPS);
        const f32x4 g0 = *(const f32x4*)(gk + 8 * ch), g1 = *(const f32x4*)(gk + 8 * ch + 4);
        u32x4 o; o.x = cvtpk(x[0] * inv * g0[0], x[1] * inv * g0[1]); o.y = cvtpk(x[2] * inv * g0[2], x[3] * inv * g0[3]); o.z = cvtpk(x[4] * inv * g1[0], x[5] * inv * g1[1]); o.w = cvtpk(x[6] * inv * g1[2], x[7] * inv * g1[3]);
        *(u32x4*)(KDN + (size_t)row * 64 + 8 * ch) = o;
    }
}
__device__ __forceinline__ void topk_phase(const bf16* IDXP, const float* gk, float* scores, unsigned short* SEL, bf16* KDN, LAS unsigned char* shm, int vcu, int G) {
    for (int v = vcu; v < 256; v += G) {
        kdn_rows(IDXP, gk, KDN, v * 64, 64, threadIdx.x);
        float* scr = scores + (size_t)v * 32 * 4096;
        const int b = v >> 6, j = v & 63;
        topk_unit(b, j, IDXP, scr, SEL, shm);
        topk_unit(b, 127 - j, IDXP, scr, SEL, shm);
    }
}

constexpr int AV_ROW = 160, AW_BYTES = 512 + 64 * AV_ROW;
constexpr int ATT_LDS_BYTES = 8 * AW_BYTES;
__device__ __forceinline__ s16x4 vtr(const LAS unsigned char* p) { return __builtin_bit_cast(s16x4, __builtin_amdgcn_ds_read_tr16_b64_v4i16((LAS v4i16_t*)p)); }
__device__ __forceinline__ void dsa_query(int m, const bf16* P2, const bf16* IDXP, const bf16* KDN, const unsigned short* SEL, const float* gq, bf16* YD, LAS unsigned char* wl, int lane) {
    const int b = m / SEQ, t = m - b * SEQ; const size_t rowbase = (size_t)b * SEQ;
    const int nsel = (t + 1 < 256) ? t + 1 : 256;
    const int h16 = lane & 15, dq = lane >> 4;
    LAS unsigned short* sl = (LAS unsigned short*)wl; LAS unsigned char* vt = wl + 512;
    { u32x2 v = *(const u32x2*)(SEL + (size_t)m * 256 + 4 * lane);
      if (4 * lane + 0 >= nsel) v.x &= 0xffff0000u; if (4 * lane + 1 >= nsel) v.x &= 0x0000ffffu; if (4 * lane + 2 >= nsel) v.y &= 0xffff0000u; if (4 * lane + 3 >= nsel) v.y &= 0x0000ffffu;
      *(LAS u32x2*)(sl + 4 * lane) = v; }
    bf16x8 qf[2];
    { float x[16];
      if (h16 < 8) {
          const u32x4 v0 = *(const u32x4*)(P2 + (size_t)m * 2048 + PB_QD + 64 * h16 + 8 * dq), v1 = *(const u32x4*)(P2 + (size_t)m * 2048 + PB_QD + 64 * h16 + 32 + 8 * dq);
          x[0] = blo(v0.x); x[1] = bhi(v0.x); x[2] = blo(v0.y); x[3] = bhi(v0.y); x[4] = blo(v0.z); x[5] = bhi(v0.z); x[6] = blo(v0.w); x[7] = bhi(v0.w);
          x[8] = blo(v1.x); x[9] = bhi(v1.x); x[10] = blo(v1.y); x[11] = bhi(v1.y); x[12] = blo(v1.z); x[13] = bhi(v1.z); x[14] = blo(v1.w); x[15] = bhi(v1.w);
      } else {
#pragma unroll
          for (int e = 0; e < 16; ++e) x[e] = 0.f; }
      float ss = 0.f;
#pragma unroll
      for (int e = 0; e < 16; ++e) ss += x[e] * x[e];
      ss += __shfl_xor(ss, 16); ss += __shfl_xor(ss, 32);
      const float inv = (1.0f / sqrtf(ss * (1.f / 64.f) + RMS_EPS)) * (0.125f * 1.4426950408889634f);
      const f32x4 g0 = *(const f32x4*)(gq + 8 * dq), g1 = *(const f32x4*)(gq + 8 * dq + 4), g2 = *(const f32x4*)(gq + 32 + 8 * dq), g3 = *(const f32x4*)(gq + 32 + 8 * dq + 4);
      u32x4 w0, w1;
      w0.x = cvtpk(x[0] * inv * g0[0], x[1] * inv * g0[1]); w0.y = cvtpk(x[2] * inv * g0[2], x[3] * inv * g0[3]); w0.z = cvtpk(x[4] * inv * g1[0], x[5] * inv * g1[1]); w0.w = cvtpk(x[6] * inv * g1[2], x[7] * inv * g1[3]);
      w1.x = cvtpk(x[8] * inv * g2[0], x[9] * inv * g2[1]); w1.y = cvtpk(x[10] * inv * g2[2], x[11] * inv * g2[3]); w1.z = cvtpk(x[12] * inv * g3[0], x[13] * inv * g3[1]); w1.w = cvtpk(x[14] * inv * g3[2], x[15] * inv * g3[3]);
      qf[0] = __builtin_bit_cast(bf16x8, w0); qf[1] = __builtin_bit_cast(bf16x8, w1); }
    asm volatile("s_waitcnt lgkmcnt(0)" ::: "memory");
    f32x4 acc[16];
#pragma unroll
    for (int g = 0; g < 16; ++g) { const int kidx = sl[16 * g + h16];
        const bf16* kr = KDN + (rowbase + kidx) * 64 + 8 * dq;
        const bf16x8 a0 = *(const bf16x8*)kr, a1 = *(const bf16x8*)(kr + 32);
        f32x4 c = (f32x4){0.f, 0.f, 0.f, 0.f};
        c = __builtin_amdgcn_mfma_f32_16x16x32_bf16(a0, qf[0], c, 0, 0, 0); c = __builtin_amdgcn_mfma_f32_16x16x32_bf16(a1, qf[1], c, 0, 0, 0); acc[g] = c; }
    const float slope2 = __builtin_amdgcn_exp2f(-(float)((h16 & 7) + 1)) * 1.4426950408889634f;
    float mx = -INFINITY;
#pragma unroll
    for (int g = 0; g < 16; ++g) { const u32x2 kk = *(const LAS u32x2*)(sl + 16 * g + 4 * dq);
        const int kp[4] = {(int)(kk.x & 0xffffu), (int)(kk.x >> 16), (int)(kk.y & 0xffffu), (int)(kk.y >> 16)};
#pragma unroll
        for (int r = 0; r < 4; ++r) { const int slot = 16 * g + 4 * dq + r; float v = acc[g][r] - slope2 * (float)(t - kp[r]); v = (slot < nsel) ? v : -INFINITY; acc[g][r] = v; mx = fmaxf(mx, v); } }
    mx = fmaxf(mx, __shfl_xor(mx, 16)); mx = fmaxf(mx, __shfl_xor(mx, 32));
    float sum = 0.f;
#pragma unroll
    for (int g = 0; g < 16; ++g)
#pragma unroll
        for (int r = 0; r < 4; ++r) { const float p = __builtin_amdgcn_exp2f(acc[g][r] - mx); acc[g][r] = p; sum += p; }
    sum += __shfl_xor(sum, 16); sum += __shfl_xor(sum, 32);
    const float rs = 1.0f / sum;
    f32x4 o[4];
#pragma unroll
    for (int d = 0; d < 4; ++d) o[d] = (f32x4){0.f, 0.f, 0.f, 0.f};
#pragma unroll
    for (int c = 0; c < 4; ++c) {
        u32x4 vr[8];
#pragma unroll
        for (int i = 0; i < 8; ++i) { const int slot = (lane >> 3) + 8 * i, part = lane & 7; const int kidx = sl[64 * c + slot];
            vr[i] = *(const u32x4*)(IDXP + (rowbase + kidx) * NA + IA_VD + 8 * part); }
#pragma unroll
        for (int i = 0; i < 8; ++i) { const int slot = (lane >> 3) + 8 * i, part = lane & 7; *(LAS u32x4*)(vt + slot * AV_ROW + part * 16) = vr[i]; }
        asm volatile("s_waitcnt lgkmcnt(0)" ::: "memory");
#pragma unroll
        for (int s2 = 0; s2 < 2; ++s2) { const int g0 = 4 * c + 2 * s2;
            u32x4 pw; pw.x = cvtpk(acc[g0][0] * rs, acc[g0][1] * rs); pw.y = cvtpk(acc[g0][2] * rs, acc[g0][3] * rs); pw.z = cvtpk(acc[g0 + 1][0] * rs, acc[g0 + 1][1] * rs); pw.w = cvtpk(acc[g0 + 1][2] * rs, acc[g0 + 1][3] * rs);
            const LAS unsigned char* vb = vt + (32 * s2 + 4 * dq + ((lane & 15) >> 2)) * AV_ROW + (lane & 3) * 8;
#pragma unroll
            for (int d = 0; d < 4; ++d) { const s16x4 lo = vtr(vb + d * 32), hh = vtr(vb + 16 * AV_ROW + d * 32);
                const bf16x8 vf = (bf16x8){lo[0], lo[1], lo[2], lo[3], hh[0], hh[1], hh[2], hh[3]};
                o[d] = __builtin_amdgcn_mfma_f32_16x16x32_bf16(__builtin_bit_cast(bf16x8, pw), vf, o[d], 0, 0, 0); } }
        asm volatile("s_waitcnt lgkmcnt(0)" ::: "memory");
    }
    if (dq < 2) {
#pragma unroll
        for (int d = 0; d < 4; ++d)
#pragma unroll
            for (int r = 0; r < 4; ++r) YD[(size_t)m * 512 + (4 * dq + r) * 64 + 16 * d + h16] = (bf16)f2bf(o[d][r]);
    }
}
__device__ __forceinline__ void dsa_att_phase(const bf16* P2, const bf16* IDXP, const bf16* KDN, const unsigned short* SEL, const float* gq, bf16* YD, LAS unsigned char* shm, int vcu, int G) {
    const int lane = threadIdx.x & 63; const int wid = __builtin_amdgcn_readfirstlane(threadIdx.x >> 6);
    LAS unsigned char* wl = shm + wid * AW_BYTES;
    for (int m = vcu * 8 + wid; m < M; m += G * 8) dsa_query(m, P2, IDXP, KDN, SEL, gq, YD, wl, lane);
}
}
struct Frame {
    LAS unsigned char* lds;
    volatile LAS unsigned* MISC;
    gu32* ctl;
    int tid, lane, wave, vcu, G;
    unsigned char* ws;
    const float* in[21]; float* out;
};
enum { I_X = 0, I_C, I_WADA, I_BADA, I_GFFN1, I_W1A, I_W3A, I_W2A, I_GMIX, I_WIN, I_GQ, I_GK, I_WPSB, I_WPD, I_WGATE, I_BGATE, I_WOUT, I_GFFN2, I_W1B, I_W3B, I_W2B };

__device__ __forceinline__ float wave_sum(float v) {
#pragma unroll
    for (int o = 1; o < 64; o <<= 1) v += __shfl_xor(v, o);
    return v;
}
__device__ __forceinline__ void tr_item(const float* W, int ldw, int c0, int nvalid, int k0, bf16* WT, int K, int drow0, LAS float* scr, int lane) {
    const int n = lane & 31;
#pragma unroll 8
    for (int i = 0; i < 32; ++i) { const int kk = 2 * i + (lane >> 5); scr[kk * 33 + n] = (n < nvalid) ? W[(size_t)(k0 + kk) * ldw + c0 + n] : 0.f; }
    LDS_WAIT(); asm volatile("" ::: "memory");
    const int c = lane & 7;
#pragma unroll
    for (int j = 0; j < 4; ++j) { const int nn = (lane >> 3) + 8 * j; const LAS float* s = scr + (8 * c) * 33 + nn;
        v4u o; o.x = pk2(s[0 * 33], s[1 * 33]); o.y = pk2(s[2 * 33], s[3 * 33]); o.z = pk2(s[4 * 33], s[5 * 33]); o.w = pk2(s[6 * 33], s[7 * 33]);
        *(GAS v4u*)(WT + (size_t)(drow0 + nn) * K + k0 + 8 * c) = o; }
    LDS_WAIT(); asm volatile("" ::: "memory");
}
__device__ __forceinline__ bool tr_seg(int& r, const float* W, int ldw, int K, int c0, int ncb, int nvalid_last, bf16* WT, int drow0, int kind, LAS float* scr, int lane) {
    const int items = (K / 64) * ncb;
    if (r >= items) { r -= items; return false; }
    const int kb = r / ncb, cb = r % ncb, col = c0 + 32 * cb;
    const int nvalid = (cb == ncb - 1) ? nvalid_last : 32;
    int drow;
    if (kind == 0) drow = drow0 + 32 * cb; else drow = 256 * (col / 128) + (col % 128) + (kind == 2 ? 128 : 0);
    tr_item(W, ldw, col, nvalid, 64 * kb, WT, K, drow, scr, lane);
    return true;
}
__device__ __forceinline__ void p0_prologue(Frame& F) {
    LAS float* scr = (LAS float*)(F.lds + RING_OFF + F.wave * 16384);
    const int gw = F.vcu * NWAVES + F.wave, NGW = F.G * NWAVES;
    bf16* W13_1 = (bf16*)(F.ws + WS_W13_1); bf16* W2_1 = (bf16*)(F.ws + WS_W2_1); bf16* W13_2 = (bf16*)(F.ws + WS_W13_2); bf16* W2_2 = (bf16*)(F.ws + WS_W2_2);
    bf16* WA = (bf16*)(F.ws + WS_WA); bf16* WB = (bf16*)(F.ws + WS_WB); bf16* WPSB = (bf16*)(F.ws + WS_WPSB); bf16* WPD = (bf16*)(F.ws + WS_WPD); bf16* WOUT = (bf16*)(F.ws + WS_WOUT);
    constexpr int NITEMS = 6 * 1408 + 1024 + 1024 + 288 + 16 + 16 + 64 + 256 + 256 + 512;
    for (int it = gw; it < NITEMS; it += NGW) {
        int r = it;
        if (tr_seg(r, F.in[I_W1A], FF, D, 0, 88, 32, W13_1, 0, 1, scr, F.lane)) continue;
        if (tr_seg(r, F.in[I_W3A], FF, D, 0, 88, 32, W13_1, 0, 2, scr, F.lane)) continue;
        if (tr_seg(r, F.in[I_W2A], D, FF, 0, 32, 32, W2_1, 0, 0, scr, F.lane)) continue;
        if (tr_seg(r, F.in[I_W1B], FF, D, 0, 88, 32, W13_2, 0, 1, scr, F.lane)) continue;
        if (tr_seg(r, F.in[I_W3B], FF, D, 0, 88, 32, W13_2, 0, 2, scr, F.lane)) continue;
        if (tr_seg(r, F.in[I_W2B], D, FF, 0, 32, 32, W2_2, 0, 0, scr, F.lane)) continue;
        if (tr_seg(r, F.in[I_WIN], DIN, D, 0, 64, 32, WB, 0, 0, scr, F.lane)) continue;
        if (tr_seg(r, F.in[I_WGATE], 2048, D, 0, 64, 32, WB, 2048, 0, scr, F.lane)) continue;
        if (tr_seg(r, F.in[I_WIN], DIN, D, 2176, 18, 32, WA, 0, 0, scr, F.lane)) continue;
        if (tr_seg(r, F.in[I_WIN], DIN, D, 2752, 1, 8, WA, 576, 0, scr, F.lane)) continue;
        if (tr_seg(r, F.in[I_WIN], DIN, D, 0, 1, 0, WA, 608, 0, scr, F.lane)) continue;
        if (tr_seg(r, F.in[I_WIN], DIN, D, 2048, 4, 32, WA, 640, 0, scr, F.lane)) continue;
        if (tr_seg(r, F.in[I_WPSB], D, 512, 0, 32, 32, WPSB, 0, 0, scr, F.lane)) continue;
        if (tr_seg(r, F.in[I_WPD], D, 512, 0, 32, 32, WPD, 0, 0, scr, F.lane)) continue;
        tr_seg(r, F.in[I_WOUT], D, D, 0, 32, 32, WOUT, 0, 0, scr, F.lane);
    }
    __syncthreads();
    LAS float* sc = (LAS float*)(F.lds + RING_OFF);
    LAS float* red = (LAS float*)(F.lds + RING_OFF + 16384);
    for (int i = F.tid; i < 4096; i += NWAVES * 64) { const float v = F.in[I_C][i]; sc[i] = v / (1.f + __expf(-v)); }
    __syncthreads();
    float* MOD = (float*)(F.ws + WS_MOD);
    for (int sl = F.vcu; sl < 256; sl += F.G) {
        const int cq = F.tid % 9, rg = F.tid / 9;
        if (rg < 56) {
            float a[4][4];
#pragma unroll
            for (int b = 0; b < 4; ++b)
#pragma unroll
                for (int e = 0; e < 4; ++e) a[b][e] = 0.f;
            for (int k = rg; k < 1024; k += 56) { const f32x4 w = *(const GAS f32x4*)(F.in[I_WADA] + (size_t)k * NMOD + 36 * sl + 4 * cq);
#pragma unroll
                for (int b = 0; b < 4; ++b) { const float s = sc[b * 1024 + k];
#pragma unroll
                    for (int e = 0; e < 4; ++e) a[b][e] += s * w[e]; } }
#pragma unroll
            for (int b = 0; b < 4; ++b)
#pragma unroll
                for (int e = 0; e < 4; ++e) red[(rg * 9 + cq) * 16 + b * 4 + e] = a[b][e];
        }
        __syncthreads();
        if (F.tid < 144) { const int b = F.tid / 36, j = F.tid % 36, cq = j >> 2, e = j & 3; float s = 0.f;
            for (int g = 0; g < 56; ++g) s += red[(g * 9 + cq) * 16 + b * 4 + e];
            MOD[b * NMOD + 36 * sl + j] = s + F.in[I_BADA][36 * sl + j]; }
        __syncthreads();
    }
}
__device__ __forceinline__ void norm_phase(Frame& F, const float* xin, const float* g, int shift_chunk, int scale_chunk) {
    const int gw = F.vcu * NWAVES + F.wave, NGW = F.G * NWAVES;
    const float* MOD = (const float*)(F.ws + WS_MOD); bf16* XN = (bf16*)(F.ws + WS_XN);
    for (int m = gw; m < M; m += NGW) {
        const int b = m / SEQ;
        const GAS f32x4* xr = (const GAS f32x4*)(xin + (size_t)m * D) + F.lane;
        const GAS f32x4* gr = (const GAS f32x4*)g + F.lane;
        const GAS f32x4* shr = (const GAS f32x4*)(MOD + (size_t)b * NMOD + shift_chunk * 1024) + F.lane;
        const GAS f32x4* scr = (const GAS f32x4*)(MOD + (size_t)b * NMOD + scale_chunk * 1024) + F.lane;
        f32x4 v[4]; float s = 0.f;
#pragma unroll
        for (int j = 0; j < 4; ++j) { v[j] = xr[64 * j]; s += (v[j].x * v[j].x + v[j].y * v[j].y) + (v[j].z * v[j].z + v[j].w * v[j].w); }
        const float inv = 1.f / sqrtf(wave_sum(s) * (1.f / D) + RMS_EPS);
        GAS unsigned long long* o8 = (GAS unsigned long long*)(XN + (size_t)m * D) + F.lane;
#pragma unroll
        for (int j = 0; j < 4; ++j) { const f32x4 gg = gr[64 * j], sh = shr[64 * j], sc = scr[64 * j];
            const f32x4 y = v[j] * inv * gg * (sc + 1.0f) + sh;
            o8[64 * j] = (unsigned long long)pk2(y.x, y.y) | ((unsigned long long)pk2(y.z, y.w) << 32); }
    }
}

struct Args { const float* in[21]; float* out; unsigned char* ws; int ph_lo, ph_hi; };
enum { PH_PRO = 0, PH_NORM1, PH_UP1, PH_DOWN1, PH_NORM2, PH_GA, PH_TOPK, PH_GB, PH_ATT, PH_PSB, PH_PD, PH_WOUT, PH_NORM3, PH_UP2, PH_DOWN2, PH_N };
__global__ void __launch_bounds__(NWAVES * 64, 2) mk_fwd(Args args) {
    extern __shared__ __attribute__((aligned(16))) unsigned char lds[];
    Frame F;
    F.lds = (LAS unsigned char*)lds;
    F.MISC = (volatile LAS unsigned*)(F.lds + MISC_OFF);
    F.tid = threadIdx.x; F.lane = F.tid & 63; F.wave = __builtin_amdgcn_readfirstlane(F.tid >> 6);
    F.G = gridDim.x; { const int bx = blockIdx.x; F.vcu = (F.G % 8 == 0) ? (bx % 8) * (F.G / 8) + bx / 8 : bx; }
    F.ws = args.ws; F.ctl = (gu32*)(args.ws + WS_CTL); F.out = args.out;
#pragma unroll
    for (int i = 0; i < 21; ++i) F.in[i] = args.in[i];
    for (int u = F.tid; u < (LDS_BYTES - LDSCTL_OFF) / 4; u += NWAVES * 64) ((LAS unsigned*)(F.lds + LDSCTL_OFF))[u] = 0u;
    __syncthreads();
    const int lo = args.ph_lo, hi = args.ph_hi;
    XcdBarrier bar = xcd_barrier_post((unsigned*)(F.ctl + CW_BAR) + lo * XCD_BAR_WORDS, F.MISC + 8);
#define IN(k) (lo <= (k) && (k) < hi)
#define SEAM(k) do { if (IN(k) && IN((k) + 1)) xcd_barrier(bar); } while (0)
    unsigned char* ws = args.ws;
    bf16* XN = (bf16*)(ws + WS_XN); bf16* HB = (bf16*)(ws + WS_HB); const float* MOD = (const float*)(ws + WS_MOD);

    if (IN(PH_PRO)) { p0_prologue(F); } SEAM(PH_PRO);
    if (IN(PH_NORM1)) { norm_phase(F, F.in[I_X], F.in[I_GFFN1], 0, 1); } SEAM(PH_NORM1);
    if (IN(PH_UP1)) { pg8::Gemm g{XN, (const bf16*)(ws + WS_W13_1), M, 2 * FF, D}; pg8::StaticOrder S; S.init(M, 2 * FF, F.G, (int)blockIdx.x);
        pg8::EpiSwiglu E{HB, FF}; pg8::gemm_phase<pg8::EpiSwiglu, pg8::StaticOrder, true, true>(F.lds + RING_OFF, g, S, E); } SEAM(PH_UP1);
    if (IN(PH_DOWN1)) { pg8::Gemm g{HB, (const bf16*)(ws + WS_W2_1), M, D, FF}; pg8::StaticOrder S; S.init(M, D, F.G, (int)blockIdx.x);
        pg8::EpiResid E{F.in[I_X], F.out, MOD, 2, 0.5f}; pg8::gemm_phase<pg8::EpiResid, pg8::StaticOrder, true, true>(F.lds + RING_OFF, g, S, E); } SEAM(PH_DOWN1);
    if (IN(PH_NORM2)) { norm_phase(F, F.out, F.in[I_GMIX], 3, 4); } SEAM(PH_NORM2);
    if (IN(PH_GA)) { pg8::Gemm g{XN, (const bf16*)(ws + WS_WA), M, NA, D}; pg8::StaticOrder S; S.init(M, NA, F.G, (int)blockIdx.x);
        pg8::EpiPlain E{(bf16*)(ws + WS_IDXP), NA}; pg8::gemm_phase<pg8::EpiPlain, pg8::StaticOrder, true, true>(F.lds + RING_OFF, g, S, E); } SEAM(PH_GA);
#ifndef NO_TOPK
    if (IN(PH_TOPK)) { dsa::topk_phase((const bf16*)(ws + WS_IDXP), F.in[I_GK], (float*)(ws + WS_SCORES), (unsigned short*)(ws + WS_SEL), (bf16*)(ws + WS_KDN), F.lds + RING_OFF, F.vcu, F.G); }
#endif
    SEAM(PH_TOPK);
    if (IN(PH_GB)) { pg8::Gemm g{XN, (const bf16*)(ws + WS_WB), M, NB, D}; pg8::StaticOrder S; S.init(M, NB, F.G, (int)blockIdx.x);
        pg8::EpiProjB E{(bf16*)(ws + WS_P2), (bf16*)(ws + WS_GATES), F.in[I_BGATE]}; pg8::gemm_phase<pg8::EpiProjB, pg8::StaticOrder, true, true>(F.lds + RING_OFF, g, S, E); } SEAM(PH_GB);
    if (IN(PH_ATT)) { sba::sb_phase((const bf16*)(ws + WS_P2), (bf16*)(ws + WS_YSB), F.lds + RING_OFF, F.vcu, F.G); __syncthreads();
#ifndef NO_DSAATT
        dsa::dsa_att_phase((const bf16*)(ws + WS_P2), (const bf16*)(ws + WS_IDXP), (const bf16*)(ws + WS_KDN), (const unsigned short*)(ws + WS_SEL), F.in[I_GQ], (bf16*)(ws + WS_YD), F.lds + RING_OFF, F.vcu, F.G);
#endif
    } SEAM(PH_ATT);
    if (IN(PH_PSB)) { pg8::Gemm g{(const bf16*)(ws + WS_YSB), (const bf16*)(ws + WS_WPSB), M, D, 512}; pg8::StaticOrder S; S.init(M, D, F.G, (int)blockIdx.x);
        pg8::EpiGate1 E{(const bf16*)(ws + WS_GATES), (float*)(ws + WS_TMP)}; pg8::gemm_phase<pg8::EpiGate1, pg8::StaticOrder, true, true>(F.lds + RING_OFF, g, S, E); }
    if (IN(PH_PSB) && IN(PH_PD)) { VM_WAIT(); __syncthreads(); }
    if (IN(PH_PD)) { pg8::Gemm g{(const bf16*)(ws + WS_YD), (const bf16*)(ws + WS_WPD), M, D, 512}; pg8::StaticOrder S; S.init(M, D, F.G, (int)blockIdx.x);
        pg8::EpiGate2 E{(const bf16*)(ws + WS_GATES), (const float*)(ws + WS_TMP), (bf16*)(ws + WS_MG)}; pg8::gemm_phase<pg8::EpiGate2, pg8::StaticOrder, true, true>(F.lds + RING_OFF, g, S, E); } SEAM(PH_PD);
    if (IN(PH_WOUT)) { pg8::Gemm g{(const bf16*)(ws + WS_MG), (const bf16*)(ws + WS_WOUT), M, D, D}; pg8::StaticOrder S; S.init(M, D, F.G, (int)blockIdx.x);
        pg8::EpiResid E{F.out, F.out, MOD, 5, 1.0f}; pg8::gemm_phase<pg8::EpiResid, pg8::StaticOrder, true, true>(F.lds + RING_OFF, g, S, E); } SEAM(PH_WOUT);
    if (IN(PH_NORM3)) { norm_phase(F, F.out, F.in[I_GFFN2], 6, 7); } SEAM(PH_NORM3);
    if (IN(PH_UP2)) { pg8::Gemm g{XN, (const bf16*)(ws + WS_W13_2), M, 2 * FF, D}; pg8::StaticOrder S; S.init(M, 2 * FF, F.G, (int)blockIdx.x);
        pg8::EpiSwiglu E{HB, FF}; pg8::gemm_phase<pg8::EpiSwiglu, pg8::StaticOrder, true, true>(F.lds + RING_OFF, g, S, E); } SEAM(PH_UP2);
    if (IN(PH_DOWN2)) { pg8::Gemm g{HB, (const bf16*)(ws + WS_W2_2), M, D, FF}; pg8::StaticOrder S; S.init(M, D, F.G, (int)blockIdx.x);
        pg8::EpiResid E{F.out, F.out, MOD, 8, 0.5f}; pg8::gemm_phase<pg8::EpiResid, pg8::StaticOrder, true, true>(F.lds + RING_OFF, g, S, E); }
#undef IN
#undef SEAM
}

extern "C" void kernel_launch(void* const* d_in, const int* in_sizes, int n_in, void* d_out, int out_size, void* d_ws, size_t ws_size, hipStream_t stream) {
    static int grid = 0;
    if (grid == 0) {
        if (n_in != 21 || out_size != M * D || ws_size < WS_END) { fprintf(stderr, "kernel_launch: unexpected shapes (n_in %d out %d ws %zu)\n", n_in, out_size, ws_size); grid = -1; return; }
        int dev = 0, cus = 0, per_cu = 0;
        if (hipGetDevice(&dev) != hipSuccess || hipDeviceGetAttribute(&cus, hipDeviceAttributeMultiprocessorCount, dev) != hipSuccess) { grid = -1; return; }
        if (hipFuncSetAttribute((const void*)mk_fwd, hipFuncAttributeMaxDynamicSharedMemorySize, LDS_BYTES) != hipSuccess) { fprintf(stderr, "kernel_launch: hipFuncSetAttribute failed\n"); grid = -1; return; }
        if (hipOccupancyMaxActiveBlocksPerMultiprocessor(&per_cu, (const void*)mk_fwd, NWAVES * 64, LDS_BYTES) != hipSuccess || per_cu < 1) fprintf(stderr, "kernel_launch: occupancy query says %d\n", per_cu);
        (void)hipGetLastError();
        grid = cus;
    }
    if (grid < 0) return;
    (void)hipMemsetAsync((char*)d_ws + WS_CTL, 0, CTL_ZERO_BYTES, stream);
    Args a{};
    for (int i = 0; i < 21; ++i) a.in[i] = (const float*)d_in[i];
    a.out = (float*)d_out; a.ws = (unsigned char*)d_ws;
    unsigned char* ws = (unsigned char*)d_ws;
    auto run = [&](int lo, int hi) { a.ph_lo = lo; a.ph_hi = hi; hipLaunchKernelGGL(mk_fwd, dim3(grid), dim3(NWAVES * 64), LDS_BYTES, stream, a); };
    run(PH_PRO, PH_N);
}
```

```cpp
#include <hip/hip_runtime.h>
#include <cstdio>
#include <cstdint>
#include <cmath>
namespace pg8 {
#define PG8_LAS __attribute__((address_space(3)))
typedef unsigned short bf16_t;
typedef short bf16x8 __attribute__((ext_vector_type(8)));
typedef float f32x4 __attribute__((ext_vector_type(4)));
typedef unsigned u32x4 __attribute__((ext_vector_type(4)));
constexpr int BM = 256, BK = 64, HALF = 128, HTB = HALF * BK * 2  , STAGE_BYTES = 8 * HTB, NXCD = 8, WGM = 8;

__host__ __device__ __forceinline__ int lds_byte(int r, int c) { const int st = (r >> 4) * 2 + (c >> 5), rr = r & 15, cc = c & 31, ob = rr * 64 + cc * 2; return st * 1024 + (ob ^ (((ob >> 9) & 1) << 5)); }
__host__ __device__ __forceinline__ void stage_rc(int b, int& R, int& C) { const int st = b / 1024, sb = b % 1024, swz = sb ^ (((sb >> 9) & 1) << 5); R = (st >> 1) * 16 + swz / 64; C = (st & 1) * 32 + (swz % 64) / 2; }
__host__ __device__ __forceinline__ int perm32(int rho) { const int n = rho >> 4, i = rho & 15; return 8 * (i >> 2) + 4 * n + (i & 3); }

struct Unit { int pm, pn; };
struct Gemm { const bf16_t* A; const bf16_t* Bt; int M, N, K; };

struct StaticOrder {
    int nM, nN, nwg, G, c;
    __host__ __device__ void init(int M, int N, int G_, int c_) { nM = M / BM; nN = N / BM; nwg = nM * nN; G = G_; c = c_; }
    __host__ __device__ bool next(int i, Unit& u) const {
        const long L = (long)i * G + c; if (L >= nwg) return false;
        int wgid = (int)L; { const int q = nwg / NXCD, r = nwg % NXCD, xcd = wgid % NXCD, off = wgid / NXCD; wgid = (xcd < r ? xcd * (q + 1) : r * (q + 1) + (xcd - r) * q) + off; }
        const int nig = WGM * nN, gid = wgid / nig, fm = gid * WGM, gsz = (nM - fm) < WGM ? (nM - fm) : WGM;
        u.pm = fm + ((wgid % nig) % gsz); u.pn = (wgid % nig) / gsz; return true;
    }
    __device__ __forceinline__ void a_ready(const Unit&) const {}
    __device__ __forceinline__ void done(const Unit&) const {}
};
__device__ __forceinline__ unsigned cvt_pk_bf16(float lo, float hi) { unsigned r; asm volatile("v_cvt_pk_bf16_f32 %0, %1, %2" : "=v"(r) : "v"(lo), "v"(hi)); return r; }
typedef float f32x2 __attribute__((ext_vector_type(2)));
typedef unsigned u32x2 __attribute__((ext_vector_type(2)));
__device__ __forceinline__ float sigm(float x) { return __builtin_amdgcn_rcpf(1.0f + __builtin_amdgcn_exp2f(-1.4426950408889634f * x)); }
__device__ __forceinline__ float bf_lo(unsigned w) { return __uint_as_float(w << 16); }
__device__ __forceinline__ float bf_hi(unsigned w) { return __uint_as_float(w & 0xffff0000u); }
struct EpiSwiglu {
    static constexpr bool PERM = true, AFTER_DRAIN = false;
    bf16_t* O; int ldc;
    __device__ __forceinline__ void operator()(const f32x4 (&acc)[2][2][4][2], const Unit& u, int wr, int wc, int fr, int fq) const {
        const int row0 = u.pm * BM + wr * 64 + fr, col0 = u.pn * HALF + wc * 32 + 8 * fq;
#pragma unroll
        for (int ai = 0; ai < 2; ++ai)
#pragma unroll
            for (int m = 0; m < 4; ++m) { bf16_t* rowp = O + (size_t)(row0 + ai * HALF + m * 16) * ldc + col0;
                const f32x4 g0 = acc[ai][0][m][0], g1 = acc[ai][0][m][1], u0 = acc[ai][1][m][0], u1 = acc[ai][1][m][1];
                f32x4 h0, h1;
#pragma unroll
                for (int e = 0; e < 4; ++e) { h0[e] = g0[e] * sigm(g0[e]) * u0[e]; h1[e] = g1[e] * sigm(g1[e]) * u1[e]; }
                u32x4 w; w.x = cvt_pk_bf16(h0[0], h0[1]); w.y = cvt_pk_bf16(h0[2], h0[3]); w.z = cvt_pk_bf16(h1[0], h1[1]); w.w = cvt_pk_bf16(h1[2], h1[3]);
                *(u32x4*)rowp = w; }
    }
};
struct EpiPlain {
    static constexpr bool PERM = true, AFTER_DRAIN = false;
    bf16_t* O; int ldc;
    __device__ __forceinline__ void operator()(const f32x4 (&acc)[2][2][4][2], const Unit& u, int wr, int wc, int fr, int fq) const {
        const int row0 = u.pm * BM + wr * 64 + fr, col0 = u.pn * BM + wc * 32 + 8 * fq;
#pragma unroll
        for (int ai = 0; ai < 2; ++ai)
#pragma unroll
            for (int m = 0; m < 4; ++m) { bf16_t* rowp = O + (size_t)(row0 + ai * HALF + m * 16) * ldc + col0;
#pragma unroll
                for (int bj = 0; bj < 2; ++bj) { const f32x4 v0 = acc[ai][bj][m][0], v1 = acc[ai][bj][m][1];
                    u32x4 w; w.x = cvt_pk_bf16(v0[0], v0[1]); w.y = cvt_pk_bf16(v0[2], v0[3]); w.z = cvt_pk_bf16(v1[0], v1[1]); w.w = cvt_pk_bf16(v1[2], v1[3]);
                    *(u32x4*)(rowp + bj * HALF) = w; } }
    }
};
struct EpiProjB {
    static constexpr bool PERM = true, AFTER_DRAIN = false;
    bf16_t* P; bf16_t* G; const float* bias;
    __device__ __forceinline__ void operator()(const f32x4 (&acc)[2][2][4][2], const Unit& u, int wr, int wc, int fr, int fq) const {
        const bool isg = u.pn >= 8;
        const int row0 = u.pm * BM + wr * 64 + fr, col0 = (isg ? u.pn - 8 : u.pn) * BM + wc * 32 + 8 * fq;
        bf16_t* base = isg ? G : P;
        f32x4 bv[2][2];
#pragma unroll
        for (int bj = 0; bj < 2; ++bj)
#pragma unroll
            for (int n = 0; n < 2; ++n) bv[bj][n] = isg ? *(const f32x4*)(bias + col0 + bj * HALF + 4 * n) : (f32x4){0.f, 0.f, 0.f, 0.f};
#pragma unroll
        for (int ai = 0; ai < 2; ++ai)
#pragma unroll
            for (int m = 0; m < 4; ++m) { bf16_t* rowp = base + (size_t)(row0 + ai * HALF + m * 16) * 2048 + col0;
#pragma unroll
                for (int bj = 0; bj < 2; ++bj) { f32x4 v0 = acc[ai][bj][m][0] + bv[bj][0], v1 = acc[ai][bj][m][1] + bv[bj][1];
                    if (isg) {
#pragma unroll
                        for (int e = 0; e < 4; ++e) { v0[e] = sigm(v0[e]); v1[e] = sigm(v1[e]); } }
                    u32x4 w; w.x = cvt_pk_bf16(v0[0], v0[1]); w.y = cvt_pk_bf16(v0[2], v0[3]); w.z = cvt_pk_bf16(v1[0], v1[1]); w.w = cvt_pk_bf16(v1[2], v1[3]);
                    *(u32x4*)(rowp + bj * HALF) = w; } }
    }
};
struct EpiResid {
    static constexpr bool PERM = false, AFTER_DRAIN = false;
    const float* base; float* out; const float* mod; int chunk; float coef;
    __device__ __forceinline__ void operator()(const f32x4 (&acc)[2][2][4][2], const Unit& u, int wr, int wc, int fr, int fq) const {
        const int row0 = u.pm * BM + wr * 64 + fr, col0 = u.pn * BM + wc * 32 + 4 * fq;
        const float* mg = mod + (size_t)(u.pm >> 4) * 9216 + chunk * 1024 + col0;
        f32x4 gv[2][2];
#pragma unroll
        for (int bj = 0; bj < 2; ++bj)
#pragma unroll
            for (int n = 0; n < 2; ++n) gv[bj][n] = *(const f32x4*)(mg + bj * HALF + n * 16) * coef;
#pragma unroll
        for (int ai = 0; ai < 2; ++ai)
#pragma unroll
            for (int m = 0; m < 4; ++m) { const size_t off = (size_t)(row0 + ai * HALF + m * 16) * 1024 + col0;
#pragma unroll
                for (int bj = 0; bj < 2; ++bj)
#pragma unroll
                    for (int n = 0; n < 2; ++n) { const f32x4 bs = *(const f32x4*)(base + off + bj * HALF + n * 16);
                        *(f32x4*)(out + off + bj * HALF + n * 16) = bs + gv[bj][n] * acc[ai][bj][m][n]; }
                if (m & 1) asm volatile("" ::: "memory"); }
    }
};
struct EpiGate1 {
    static constexpr bool PERM = false, AFTER_DRAIN = false;
    const bf16_t* G; float* TMP;
    __device__ __forceinline__ void operator()(const f32x4 (&acc)[2][2][4][2], const Unit& u, int wr, int wc, int fr, int fq) const {
        const int row0 = u.pm * BM + wr * 64 + fr, col0 = u.pn * BM + wc * 32 + 4 * fq;
#pragma unroll
        for (int ai = 0; ai < 2; ++ai)
#pragma unroll
            for (int m = 0; m < 4; ++m) { const size_t r = (size_t)(row0 + ai * HALF + m * 16);
#pragma unroll
                for (int bj = 0; bj < 2; ++bj)
#pragma unroll
                    for (int n = 0; n < 2; ++n) { const int c = col0 + bj * HALF + n * 16; const u32x2 g = *(const u32x2*)(G + r * 2048 + c);
                        const f32x4 a = acc[ai][bj][m][n]; f32x4 o; o[0] = bf_lo(g.x) * a[0]; o[1] = bf_hi(g.x) * a[1]; o[2] = bf_lo(g.y) * a[2]; o[3] = bf_hi(g.y) * a[3];
                        *(f32x4*)(TMP + r * 1024 + c) = o; }
                if (m & 1) asm volatile("" ::: "memory"); }
    }
};
struct EpiGate2 {
    static constexpr bool PERM = true, AFTER_DRAIN = false;
    const bf16_t* G; const float* TMP; bf16_t* MG;
    __device__ __forceinline__ void operator()(const f32x4 (&acc)[2][2][4][2], const Unit& u, int wr, int wc, int fr, int fq) const {
        const int row0 = u.pm * BM + wr * 64 + fr, col0 = u.pn * BM + wc * 32 + 8 * fq;
#pragma unroll
        for (int ai = 0; ai < 2; ++ai)
#pragma unroll
            for (int m = 0; m < 4; ++m) { const size_t r = (size_t)(row0 + ai * HALF + m * 16);
#pragma unroll
                for (int bj = 0; bj < 2; ++bj) { const int c = col0 + bj * HALF;
                    const u32x4 g = *(const u32x4*)(G + r * 2048 + 1024 + c); const f32x4 t0 = *(const f32x4*)(TMP + r * 1024 + c), t1 = *(const f32x4*)(TMP + r * 1024 + c + 4);
                    const f32x4 a0 = acc[ai][bj][m][0], a1 = acc[ai][bj][m][1];
                    u32x4 w; w.x = cvt_pk_bf16(t0[0] + bf_lo(g.x) * a0[0], t0[1] + bf_hi(g.x) * a0[1]); w.y = cvt_pk_bf16(t0[2] + bf_lo(g.y) * a0[2], t0[3] + bf_hi(g.y) * a0[3]);
                    w.z = cvt_pk_bf16(t1[0] + bf_lo(g.z) * a1[0], t1[1] + bf_hi(g.z) * a1[1]); w.w = cvt_pk_bf16(t1[2] + bf_lo(g.w) * a1[2], t1[3] + bf_hi(g.w) * a1[3]);
                    *(u32x4*)(MG + r * 1024 + c) = w; }
                if (m & 1) asm volatile("" ::: "memory"); }
    }
};
template <class Epi, class Sched, bool ALIGN_EPI = false, bool SP2 = false>
__device__ __forceinline__ void gemm_phase(PG8_LAS unsigned char* lds, const Gemm g, const Sched& S, const Epi& E) {
    const int tid = threadIdx.x, wid = __builtin_amdgcn_readfirstlane(tid >> 6), lane = tid & 63, wr = wid >> 2, wc = wid & 3, fr = lane & 15, fq = lane >> 4;
    const int K = g.K, nt = K / BK;
    unsigned voffA[2], voffB[2];
#pragma unroll
    for (int i = 0; i < 2; ++i) { int R, C; stage_rc(tid * 16 + i * 8192, R, C); const int Rb = Epi::PERM ? ((R & ~31) + perm32(R & 31)) : R;
        voffA[i] = (unsigned)(R * K + C) * 2u; voffB[i] = (unsigned)(Rb * K + C) * 2u; }
    const size_t kstep = (size_t)(BK * 2);
    const size_t hstep = (size_t)HALF * K * 2;
    const size_t tstep = 2 * hstep;
    const unsigned ldsw = (unsigned)wid * 1024u;
    const int aoff = lds_byte(wr * 64 + fr, fq * 8), boff = lds_byte(wc * 32 + fr, fq * 8);
#define PG8_SA(b, h) (((b) * 2 + (h)) * HTB)
#define PG8_SB(b, h) ((4 + (b) * 2 + (h)) * HTB)
#define PG8_STAGE(bufoff, gbase, voff) do { _Pragma("unroll") for (int _i = 0; _i < 2; ++_i) \
        __builtin_amdgcn_global_load_lds((const unsigned*)((const char*)(gbase) + (voff)[_i]), (PG8_LAS unsigned*)(lds + (bufoff) + ldsw + _i * 8192), 16, 0, 0); } while (0)
#define PG8_LDA(dst, b, h) do { _Pragma("unroll") for (int m = 0; m < 4; ++m) _Pragma("unroll") for (int k = 0; k < 2; ++k) dst[m][k] = *(const PG8_LAS bf16x8*)(lds + PG8_SA(b, h) + aoff + m * 2048 + k * 1024); } while (0)
#define PG8_LDB(dst, b, h) do { _Pragma("unroll") for (int n = 0; n < 2; ++n) _Pragma("unroll") for (int k = 0; k < 2; ++k) dst[n][k] = *(const PG8_LAS bf16x8*)(lds + PG8_SB(b, h) + boff + n * 2048 + k * 1024); } while (0)
#define PG8_MMA(ai, bj, At, Bt) do { __builtin_amdgcn_s_setprio(1); _Pragma("unroll") for (int m = 0; m < 4; ++m) _Pragma("unroll") for (int n = 0; n < 2; ++n) _Pragma("unroll") for (int k = 0; k < 2; ++k) \
        acc[ai][bj][m][n] = __builtin_amdgcn_mfma_f32_16x16x32_bf16(Bt[n][k], At[m][k], acc[ai][bj][m][n], 0, 0, 0); __builtin_amdgcn_s_setprio(0); } while (0)
#define PG8_WAIT_V(n) asm volatile("s_waitcnt vmcnt(" #n ")" ::: "memory")
#define PG8_WAIT_L(n) asm volatile("s_waitcnt lgkmcnt(" #n ")" ::: "memory")
#define PG8_BAR __builtin_amdgcn_s_barrier()
#define PG8_SCHED __builtin_amdgcn_sched_barrier(0)
    Unit cur, nxt; int ui = 0;
    if (!S.next(0, cur)) return;
    f32x4 acc[2][2][4][2];
#pragma unroll
    for (int a = 0; a < 2; ++a)
#pragma unroll
        for (int b = 0; b < 2; ++b)
#pragma unroll
            for (int m = 0; m < 4; ++m)
#pragma unroll
                for (int n = 0; n < 2; ++n) acc[a][b][m][n] = (f32x4){0.f, 0.f, 0.f, 0.f};
    bf16x8 At[4][2], B0[2][2], B1[2][2];
    const char* cA = (const char*)g.A + (size_t)cur.pm * tstep; const char* cB = (const char*)g.Bt + (size_t)cur.pn * tstep;
    S.a_ready(cur);
    if constexpr (SP2) {
        PG8_STAGE(PG8_SB(0, 0), cB, voffB); PG8_STAGE(PG8_SB(0, 1), cB + hstep, voffB); PG8_STAGE(PG8_SA(0, 0), cA, voffA); PG8_STAGE(PG8_SA(0, 1), cA + hstep, voffA);
        if (wr == 1) PG8_BAR;
        PG8_WAIT_V(2); PG8_BAR;
        PG8_STAGE(PG8_SB(1, 0), cB + kstep, voffB); PG8_STAGE(PG8_SA(1, 0), cA + kstep, voffA); PG8_STAGE(PG8_SB(1, 1), cB + hstep + kstep, voffB);
        PG8_WAIT_V(6); PG8_BAR;
    } else {
        PG8_STAGE(PG8_SB(0, 0), cB, voffB); PG8_STAGE(PG8_SA(0, 0), cA, voffA); PG8_STAGE(PG8_SB(0, 1), cB + hstep, voffB); PG8_STAGE(PG8_SA(0, 1), cA + hstep, voffA);
        if (wr == 1) PG8_BAR;
        PG8_WAIT_V(4); PG8_BAR;
        PG8_STAGE(PG8_SB(1, 0), cB + kstep, voffB); PG8_STAGE(PG8_SA(1, 0), cA + kstep, voffA); PG8_STAGE(PG8_SB(1, 1), cB + hstep + kstep, voffB);
        PG8_WAIT_V(6); PG8_BAR;
    }
    for (;;) {
        const bool has_next = S.next(ui + 1, nxt);
        const char* nA = has_next ? (const char*)g.A + (size_t)nxt.pm * tstep : cA; const char* nB = has_next ? (const char*)g.Bt + (size_t)nxt.pn * tstep : cB;
        for (int t = 0; t < nt; t += 2) {
            const bool last = (t == nt - 2);
            const char* a1 = cA + (size_t)(t + 1) * kstep;
            const char* a2 = last ? nA : cA + (size_t)(t + 2) * kstep; const char* b2 = last ? nB : cB + (size_t)(t + 2) * kstep;
            const char* a3 = a2 + kstep; const char* b3 = b2 + kstep;
            if (last && has_next) S.a_ready(nxt);
            if constexpr (SP2) {
            PG8_LDB(B0, 0, 0); PG8_LDB(B1, 0, 1); PG8_SCHED; PG8_LDA(At, 0, 0); PG8_STAGE(PG8_SA(1, 1), a1 + hstep, voffA);
            PG8_WAIT_V(8); PG8_WAIT_L(0); PG8_BAR; PG8_MMA(0, 0, At, B0); PG8_MMA(0, 1, At, B1); PG8_BAR; PG8_SCHED;
            PG8_LDA(At, 0, 1); PG8_STAGE(PG8_SB(0, 0), b2, voffB); PG8_STAGE(PG8_SB(0, 1), b2 + hstep, voffB); PG8_STAGE(PG8_SA(0, 0), a2, voffA);
            PG8_WAIT_V(8); PG8_WAIT_L(0); PG8_BAR; PG8_MMA(1, 0, At, B0); PG8_MMA(1, 1, At, B1); PG8_BAR; PG8_SCHED;
            PG8_LDB(B0, 1, 0); PG8_LDB(B1, 1, 1); PG8_SCHED; PG8_LDA(At, 1, 0); PG8_STAGE(PG8_SA(0, 1), a2 + hstep, voffA);
            PG8_WAIT_V(8); PG8_WAIT_L(0); PG8_BAR; PG8_MMA(0, 0, At, B0); PG8_MMA(0, 1, At, B1); PG8_BAR; PG8_SCHED;
            PG8_LDA(At, 1, 1); PG8_STAGE(PG8_SB(1, 0), b3, voffB); PG8_STAGE(PG8_SB(1, 1), b3 + hstep, voffB); PG8_STAGE(PG8_SA(1, 0), a3, voffA);
            PG8_WAIT_V(8); PG8_WAIT_L(0); PG8_BAR; PG8_MMA(1, 0, At, B0); PG8_MMA(1, 1, At, B1); PG8_BAR; PG8_SCHED;
            } else {
            PG8_LDB(B0, 0, 0); PG8_SCHED; PG8_LDA(At, 0, 0); PG8_STAGE(PG8_SA(1, 1), a1 + hstep, voffA);
            PG8_WAIT_L(8); PG8_BAR; PG8_WAIT_L(0); PG8_MMA(0, 0, At, B0); PG8_BAR; PG8_SCHED;
            PG8_LDB(B1, 0, 1); PG8_STAGE(PG8_SB(0, 0), b2, voffB);
            PG8_BAR; PG8_WAIT_L(0); PG8_MMA(0, 1, At, B1); PG8_BAR;
            PG8_LDA(At, 0, 1); PG8_STAGE(PG8_SA(0, 0), a2, voffA);
            PG8_BAR; PG8_WAIT_L(0); PG8_MMA(1, 0, At, B0); PG8_BAR; PG8_SCHED;
            PG8_STAGE(PG8_SB(0, 1), b2 + hstep, voffB);
            PG8_WAIT_V(6); PG8_BAR; PG8_MMA(1, 1, At, B1); PG8_BAR;
            PG8_LDB(B0, 1, 0); PG8_SCHED; PG8_LDA(At, 1, 0); PG8_STAGE(PG8_SA(0, 1), a2 + hstep, voffA);
            PG8_WAIT_L(8); PG8_BAR; PG8_WAIT_L(0); PG8_MMA(0, 0, At, B0); PG8_BAR; PG8_SCHED;
            PG8_LDB(B1, 1, 1); PG8_STAGE(PG8_SB(1, 0), b3, voffB);
            PG8_BAR; PG8_WAIT_L(0); PG8_MMA(0, 1, At, B1); PG8_BAR;
            PG8_LDA(At, 1, 1); PG8_STAGE(PG8_SA(1, 0), a3, voffA);
            PG8_BAR; PG8_WAIT_L(0); PG8_MMA(1, 0, At, B0); PG8_BAR; PG8_SCHED;
            PG8_STAGE(PG8_SB(1, 1), b3 + hstep, voffB);
            PG8_WAIT_V(6); PG8_BAR; PG8_MMA(1, 1, At, B1); PG8_BAR;
            }
        }
        if constexpr (ALIGN_EPI) { if (wr == 0) PG8_BAR; }
        if constexpr (!Epi::AFTER_DRAIN) { E(acc, cur, wr, wc, fr, fq); S.done(cur); }
        if (!has_next) break;
#pragma unroll
        for (int a = 0; a < 2; ++a)
#pragma unroll
            for (int b = 0; b < 2; ++b)
#pragma unroll
                for (int m = 0; m < 4; ++m)
#pragma unroll
                    for (int n = 0; n < 2; ++n) acc[a][b][m][n] = (f32x4){0.f, 0.f, 0.f, 0.f};
        cur = nxt; cA = nA; cB = nB; ++ui;
        if constexpr (ALIGN_EPI) { if (wr == 1) PG8_BAR; }
    }
    PG8_WAIT_V(0);
    if constexpr (!ALIGN_EPI) { if (wr == 0) PG8_BAR; }
    PG8_BAR;
    if constexpr (Epi::AFTER_DRAIN) { E.fused(acc, cur, wr, wc, fr, fq, lds, wid, lane); S.done(cur); }
#undef PG8_SA
#undef PG8_SB
#undef PG8_STAGE
#undef PG8_LDA
#undef PG8_LDB
#undef PG8_MMA
#undef PG8_WAIT_V
#undef PG8_WAIT_L
#undef PG8_BAR
#undef PG8_SCHED
}
}
constexpr int NWAVES = 8;
constexpr int BATCH = 4, SEQ = 4096, D = 1024, M = BATCH * SEQ, FF = 2816, DIN = 2760, NMOD = 9216;
constexpr int NA = 768, NB = 4096;
constexpr int IA_QI = 0, IA_KI = 512, IA_WI = 576, IA_KD = 640, IA_VD = 704;
constexpr int PB_QSB = 0, PB_KSB = 512, PB_VSB = 1024, PB_QD = 1536;
constexpr float RMS_EPS = 1e-6f;
constexpr size_t MiB = 1u << 20, HMiB = 1u << 19;
constexpr size_t WS_CTL = 0, CTL_ZERO_BYTES = 1 * MiB;
constexpr size_t WS_MOD = 1 * MiB;
constexpr size_t WS_W13_1 = 2 * MiB, WS_W2_1 = 13 * MiB, WS_W13_2 = 18 * MiB + HMiB, WS_W2_2 = 29 * MiB + HMiB;
constexpr size_t WS_WA = 35 * MiB, WS_WB = 36 * MiB + HMiB, WS_WPSB = 44 * MiB + HMiB, WS_WPD = 45 * MiB + HMiB, WS_WOUT = 46 * MiB + HMiB;
constexpr size_t WS_KDN = 48 * MiB + HMiB;
constexpr size_t WS_XN = 51 * MiB;
constexpr size_t WS_YSB = 51 * MiB, WS_YD = 67 * MiB;
constexpr size_t WS_IDXP = 83 * MiB;
constexpr size_t WS_SEL = 107 * MiB;
constexpr size_t WS_MG = 83 * MiB;
constexpr size_t WS_BIG = 115 * MiB;
constexpr size_t WS_HB = WS_BIG;
constexpr size_t WS_SCORES = WS_BIG;
constexpr size_t WS_P2 = WS_BIG, WS_GATES = WS_BIG + 64 * MiB;
constexpr size_t WS_TMP = WS_BIG;
constexpr size_t WS_END = 243 * MiB;
constexpr int CW_TMO = 0, CW_CODE = 1;
constexpr int CW_BAR = 4096;

constexpr int RING_OFF = 0, RING_BYTES = 131072;
constexpr int LDSCTL_OFF = RING_BYTES, MISC_OFF = LDSCTL_OFF + 320;
constexpr int LDS_BYTES = 147456;
#define GAS __attribute__((address_space(1)))
#define LAS __attribute__((address_space(3)))
typedef unsigned short bf16;
typedef unsigned v4u __attribute__((ext_vector_type(4)));
typedef float f32x4 __attribute__((ext_vector_type(4)));
typedef short bf16x8 __attribute__((ext_vector_type(8)));
typedef GAS unsigned gu32;
typedef GAS unsigned long long gu64;
#define RLX_AGENT __ATOMIC_RELAXED, __HIP_MEMORY_SCOPE_AGENT
#define LDS_WAIT() asm volatile("s_waitcnt lgkmcnt(0)" ::: "memory")
#define VM_WAIT() asm volatile("s_waitcnt vmcnt(0)" ::: "memory")
__device__ __forceinline__ unsigned long long rt() { return __builtin_amdgcn_s_memrealtime(); }
__device__ __forceinline__ unsigned f2bf(float f) { unsigned u = __builtin_bit_cast(unsigned, f); return (u + 0x7fffu + ((u >> 16) & 1u)) >> 16; }
__device__ __forceinline__ unsigned pk2(float lo, float hi) { return f2bf(lo) | (f2bf(hi) << 16); }
#define XB_TMO      128
#define XB_XCNT(j)  (256  + 64 * (j))
#define XB_XSUB(j)  (1280 + 64 * (j))
#define XB_XGEN(j)  (2304 + 64 * (j))
#define XB_TOP      3328
#define XB_TOPGEN   3392
#define XCD_BAR_WORDS 3456
#define XB_SPIN_CAP (1u << 18)

__device__ __forceinline__ unsigned xb_ld(unsigned* p)              { return __hip_atomic_load(p, __ATOMIC_RELAXED, __HIP_MEMORY_SCOPE_AGENT); }
__device__ __forceinline__ unsigned xb_add(unsigned* p, unsigned v) { return __hip_atomic_fetch_add(p, v, __ATOMIC_RELAXED, __HIP_MEMORY_SCOPE_AGENT); }
__device__ __forceinline__ unsigned xb_xcc_id() { return (unsigned)__builtin_amdgcn_s_getreg((3 << 11) | 20) & 0xFu; }
#define XB_SPIN(cond, bar) do { unsigned _sp = 0; while (cond) { __builtin_amdgcn_s_sleep(1); \
    if ((++_sp & 255u) == 0u) { if (xb_ld(&(bar)[XB_TMO])) break; if (_sp > XB_SPIN_CAP) { atomicAdd(&(bar)[XB_TMO], 1u); break; } } } } while (0)

struct XcdBarrier {
    unsigned* bar; unsigned x;
    volatile LAS unsigned* st;
};

__device__ __forceinline__ XcdBarrier xcd_barrier_post(unsigned* bar, volatile LAS unsigned* st) {
    XcdBarrier b; b.bar = bar; b.x = xb_xcc_id(); b.st = st;
    if (threadIdx.x == 0) (void)xb_add(&bar[XB_XCNT(b.x)], 1u);
    return b;
}
__device__ __forceinline__ void xcd_barrier_complete(unsigned* bar, unsigned x, unsigned& nloc, unsigned& nx) {
    const unsigned G = gridDim.x * gridDim.y * gridDim.z;
    unsigned sum, cnt, mine, sp = 0u;
    for (;;) {
        sum = 0u; cnt = 0u; mine = 0u;
#pragma unroll
        for (unsigned j = 0; j < 16; ++j) { const unsigned c = xb_ld(&bar[XB_XCNT(j)]); sum += c; cnt += (c > 0u) ? 1u : 0u; mine = (j == x) ? c : mine; }
        if (sum == G) break;
        __builtin_amdgcn_s_sleep(1);
        if ((++sp & 255u) == 0u) { if (xb_ld(&bar[XB_TMO])) break; if (sp > XB_SPIN_CAP) { atomicAdd(&bar[XB_TMO], 1u); break; } }
    }
    nloc = mine > 0u ? mine : 1u; nx = cnt > 0u ? cnt : 1u;
}

__device__ __forceinline__ void xcd_barrier(const XcdBarrier& b) {
    asm volatile("s_waitcnt vmcnt(0)" ::: "memory");
    __syncthreads();
    if (threadIdx.x == 0) {
        unsigned* bar = b.bar;
        __builtin_amdgcn_s_waitcnt(0);
        unsigned nloc = b.st[0], nx = b.st[1];
        if (nloc == 0u) { xcd_barrier_complete(bar, b.x, nloc, nx); b.st[0] = nloc; b.st[1] = nx; }
        const unsigned old = xb_add(&bar[XB_XSUB(b.x)], 1u);
        const unsigned gen = old / nloc;
        if (old + 1u == (gen + 1u) * nloc) {
            __builtin_amdgcn_fence(__ATOMIC_RELEASE, "agent");
            asm volatile("s_waitcnt vmcnt(0)" ::: "memory");
            const unsigned og = xb_add(&bar[XB_TOP], 1u);
            const unsigned tg = og / nx;
            if (og + 1u == (tg + 1u) * nx) xb_add(&bar[XB_TOPGEN], 1u);
            else XB_SPIN(xb_ld(&bar[XB_TOPGEN]) == tg, bar);
            __builtin_amdgcn_fence(__ATOMIC_ACQUIRE, "agent");
            xb_add(&bar[XB_XGEN(b.x)], 1u);
            asm volatile("s_waitcnt vmcnt(0)" ::: "memory");
        } else {
            XB_SPIN(xb_ld(&bar[XB_XGEN(b.x)]) == gen, bar);
            __builtin_amdgcn_fence(__ATOMIC_ACQUIRE, "agent");
            asm volatile("s_waitcnt vmcnt(0)" ::: "memory");
        }
    }
    __syncthreads();
}
namespace sba {
typedef short bf16x8 __attribute__((ext_vector_type(8)));
typedef short s16x4 __attribute__((ext_vector_type(4)));
typedef short v4i16_t __attribute__((ext_vector_type(4)));
typedef float f32x16 __attribute__((ext_vector_type(16)));
typedef unsigned u32x4 __attribute__((ext_vector_type(4)));
constexpr int KOFF = 0, VOFF = 16384, FLAG_OFF = 32768, OST_OFF = 33024, SB_LDS_BYTES = OST_OFF + 8 * 4096;
__device__ __forceinline__ int crow(int r, int hi) { return (r & 3) + 8 * (r >> 2) + 4 * hi; }
__device__ __forceinline__ unsigned cvtpk(float lo, float hi) { unsigned r; asm volatile("v_cvt_pk_bf16_f32 %0, %1, %2" : "=v"(r) : "v"(lo), "v"(hi)); return r; }
__device__ __forceinline__ s16x4 vtr(const LAS unsigned char* p) { return __builtin_bit_cast(s16x4, __builtin_amdgcn_ds_read_tr16_b64_v4i16((LAS v4i16_t*)p)); }

__device__ __forceinline__ void sb_unit(int b, int h, int qb, const bf16* P2, bf16* Y, LAS unsigned char* shm) {
    const int tid = threadIdx.x, lane = tid & 63, r32 = lane & 31, hi = lane >> 5; const int wid = __builtin_amdgcn_readfirstlane(tid >> 6);
    const size_t rowbase = (size_t)b * SEQ; const int q0 = qb * 256;
    const int tmin = q0 + 32 * wid, t = tmin + r32, tmax = tmin + 31;
    const bf16* Qw = P2 + (rowbase + tmin) * 2048 + PB_QSB + h * 64;
    const bf16* Kh = P2 + rowbase * 2048 + PB_KSB + h * 64; const bf16* Vh = P2 + rowbase * 2048 + PB_VSB + h * 64;
    const bf16* ksrc = Kh + (size_t)lane * 2048 + wid * 8;
    const bf16* vsrc = Vh + (size_t)(16 * (wid & 3) + (lane >> 2)) * 2048 + (wid >> 2) * 32 + (lane & 3) * 8;
    bf16x8 qr[4];
#pragma unroll
    for (int d0 = 0; d0 < 4; ++d0) qr[d0] = *(const bf16x8*)(Qw + (size_t)r32 * 2048 + d0 * 16 + hi * 8);
    volatile LAS unsigned* flags = (volatile LAS unsigned*)(shm + FLAG_OFF);
    float carry = 1.0f; f32x16 o[2]; o[0] = f32x16{}; o[1] = f32x16{};
    const int nt = 4 * qb + 4;
#define SB_STAGE(kt, buf) do { \
        __builtin_amdgcn_global_load_lds((const unsigned*)(ksrc + (size_t)(kt) * 64 * 2048), (LAS unsigned*)(shm + KOFF + (buf) * 8192 + wid * 1024), 16, 0, 0); \
        __builtin_amdgcn_global_load_lds((const unsigned*)(vsrc + (size_t)(kt) * 64 * 2048), (LAS unsigned*)(shm + VOFF + (buf) * 8192 + wid * 1024), 16, 0, 0); } while (0)
    SB_STAGE(nt - 1, 0);
    int it = 0;
    for (int kt = nt - 1; kt >= 0; --kt, ++it) {
        const int cur = it & 1;
        asm volatile("s_waitcnt vmcnt(0)" ::: "memory");
        __syncthreads();
        if (it > 0) { unsigned alld = 1u;
#pragma unroll
            for (int w = 0; w < 8; ++w) alld &= flags[((it - 1) & 1) * 8 + w];
            if (alld) break; }
        if (kt > 0) SB_STAGE(kt - 1, cur ^ 1);
        bool wdone = __builtin_amdgcn_ballot_w64(carry != 0.0f) == 0ull;
        if (64 * kt < tmax && !wdone) {
            const LAS unsigned char* kb = shm + KOFF + cur * 8192 + hi * 1024 + r32 * 16;
            f32x16 p0 = f32x16{}, p1 = f32x16{};
#pragma unroll
            for (int d0 = 0; d0 < 4; ++d0) { const bf16x8 k0 = *(const LAS bf16x8*)(kb + d0 * 2048), k1 = *(const LAS bf16x8*)(kb + d0 * 2048 + 512);
                p0 = __builtin_amdgcn_mfma_f32_32x32x16_bf16(k0, qr[d0], p0, 0, 0, 0); p1 = __builtin_amdgcn_mfma_f32_32x32x16_bf16(k1, qr[d0], p1, 0, 0, 0); }
            const float C = 0.125f * 1.4426950408889634f;
            f32x16 B0, B1;
#pragma unroll
            for (int r = 0; r < 16; ++r) {
                { const float zs = fminf(fmaxf(p0[r] * C, -100.f), 100.f), e = __builtin_amdgcn_exp2f(zs), rr = __builtin_amdgcn_rcpf(1.0f + e); B0[r] = e * rr; p0[r] = rr; }
                { const float zs = fminf(fmaxf(p1[r] * C, -100.f), 100.f), e = __builtin_amdgcn_exp2f(zs), rr = __builtin_amdgcn_rcpf(1.0f + e); B1[r] = e * rr; p1[r] = rr; } }
            if (64 * kt + 63 >= tmin) {
#pragma unroll
                for (int r = 0; r < 16; ++r) { const int key = 64 * kt + crow(r, hi);
                    if (key >= t) { p0[r] = 1.0f; B0[r] = 0.f; }
                    if (key + 32 >= t) { p1[r] = 1.0f; B1[r] = 0.f; } } }
            float s0[8], s1[8], s2[8], gp[8], isuf[9];
#pragma unroll
            for (int g = 0; g < 8; ++g) { const float x0 = g < 4 ? p0[4 * g] : p1[4 * (g - 4)], x1 = g < 4 ? p0[4 * g + 1] : p1[4 * (g - 4) + 1], x2 = g < 4 ? p0[4 * g + 2] : p1[4 * (g - 4) + 2], x3 = g < 4 ? p0[4 * g + 3] : p1[4 * (g - 4) + 3];
                s2[g] = x3; s1[g] = x3 * x2; s0[g] = s1[g] * x1; gp[g] = s0[g] * x0; }
            isuf[8] = 1.0f;
#pragma unroll
            for (int g = 7; g >= 0; --g) isuf[g] = gp[g] * isuf[g + 1];
            float tot;
            { const auto rr = __builtin_amdgcn_permlane32_swap(__float_as_uint(isuf[0]), __float_as_uint(isuf[0]), false, false); tot = __uint_as_float(rr[0]) * __uint_as_float(rr[1]); }
#pragma unroll
            for (int g = 0; g < 8; ++g) {
                const auto rr = __builtin_amdgcn_permlane32_swap(__float_as_uint(isuf[g]), __float_as_uint(isuf[g + 1]), false, false);
                const float pvv = hi ? __uint_as_float(rr[0]) : __uint_as_float(rr[1]);
                const float base = carry * isuf[g + 1] * pvv;
                if (g < 4) { p0[4 * g + 3] = B0[4 * g + 3] * base; p0[4 * g + 2] = B0[4 * g + 2] * (base * s2[g]); p0[4 * g + 1] = B0[4 * g + 1] * (base * s1[g]); p0[4 * g] = B0[4 * g] * (base * s0[g]); }
                else { const int q = 4 * (g - 4); p1[q + 3] = B1[q + 3] * base; p1[q + 2] = B1[q + 2] * (base * s2[g]); p1[q + 1] = B1[q + 1] * (base * s1[g]); p1[q] = B1[q] * (base * s0[g]); }
            }
            carry *= tot;
            u32x4 pw[4];
#pragma unroll
            for (int i = 0; i < 4; ++i) { pw[0][i] = cvtpk(p0[2 * i], p0[2 * i + 1]); pw[1][i] = cvtpk(p0[8 + 2 * i], p0[9 + 2 * i]); pw[2][i] = cvtpk(p1[2 * i], p1[2 * i + 1]); pw[3][i] = cvtpk(p1[8 + 2 * i], p1[9 + 2 * i]); }
            const LAS unsigned char* vp = shm + VOFF + cur * 8192 + ((lane >> 4) & 1) * 32 + (lane & 3) * 8 + (4 * hi + ((lane & 15) >> 2)) * 64;
#pragma unroll
            for (int d0 = 0; d0 < 2; ++d0)
#pragma unroll
                for (int ks = 0; ks < 4; ++ks) { const s16x4 lo = vtr(vp + d0 * 4096 + ks * 1024), hh = vtr(vp + d0 * 4096 + ks * 1024 + 512);
                    const bf16x8 vf = (bf16x8){lo[0], lo[1], lo[2], lo[3], hh[0], hh[1], hh[2], hh[3]};
                    o[d0] = __builtin_amdgcn_mfma_f32_32x32x16_bf16(__builtin_bit_cast(bf16x8, pw[ks]), vf, o[d0], 0, 0, 0); }
            wdone = __builtin_amdgcn_ballot_w64(carry != 0.0f) == 0ull;
        }
        if (lane == 0) flags[cur * 8 + wid] = wdone ? 1u : 0u;
    }
#undef SB_STAGE
    { LAS bf16* stg = (LAS bf16*)(shm + OST_OFF) + wid * 2048;
#pragma unroll
      for (int r = 0; r < 16; ++r) { const int orow = crow(r, hi);
#pragma unroll
          for (int d0 = 0; d0 < 2; ++d0) stg[orow * 64 + d0 * 32 + r32] = (bf16)f2bf(o[d0][r]); }
      asm volatile("s_waitcnt lgkmcnt(0)" ::: "memory");
      bf16* Ow = Y + (rowbase + tmin) * 512 + h * 64;
#pragma unroll
      for (int i = 0; i < 4; ++i) { const int row = i * 8 + (lane >> 3), ch = lane & 7; const u32x4 v = *(const LAS u32x4*)(stg + row * 64 + ch * 8); *(u32x4*)(Ow + (size_t)row * 512 + ch * 8) = v; } }
    asm volatile("s_waitcnt vmcnt(0) lgkmcnt(0)" ::: "memory");
    __syncthreads();
}
__device__ __forceinline__ void sb_phase(const bf16* P2, bf16* Y, LAS unsigned char* shm, int vcu, int G) {
    for (int u = vcu; u < BATCH * 8 * 16; u += G) sb_unit(u >> 7, (u >> 4) & 7, u & 15, P2, Y, shm);
}
}
namespace dsa {
typedef short bf16x8 __attribute__((ext_vector_type(8)));
typedef short s16x4 __attribute__((ext_vector_type(4)));
typedef short v4i16_t __attribute__((ext_vector_type(4)));
typedef float f32x16 __attribute__((ext_vector_type(16)));
typedef float f32x4 __attribute__((ext_vector_type(4)));
typedef unsigned u32x4 __attribute__((ext_vector_type(4)));
typedef unsigned u32x2 __attribute__((ext_vector_type(2)));
__device__ __forceinline__ int crow(int r, int hi) { return (r & 3) + 8 * (r >> 2) + 4 * hi; }
__device__ __forceinline__ unsigned cvtpk(float lo, float hi) { unsigned r; asm volatile("v_cvt_pk_bf16_f32 %0, %1, %2" : "=v"(r) : "v"(lo), "v"(hi)); return r; }
__device__ __forceinline__ float blo(unsigned w) { return __uint_as_float(w << 16); }
__device__ __forceinline__ float bhi(unsigned w) { return __uint_as_float(w & 0xffff0000u); }
__device__ __forceinline__ unsigned f2key(float f) { f = f + 0.0f; const unsigned u = __float_as_uint(f); return (u & 0x80000000u) ? ~u : (u | 0x80000000u); }
__device__ __forceinline__ int wsum_i(int v) {
#pragma unroll
    for (int o = 1; o < 64; o <<= 1) v += __shfl_xor(v, o);
    return v;
}
__device__ __forceinline__ void cnt_ge(int& c, unsigned k, unsigned cand) { asm volatile("v_cmp_ge_u32 vcc, %1, %2\n\tv_addc_co_u32 %0, vcc, 0, %0, vcc" : "+v"(c) : "v"(k), "v"(cand) : "vcc"); }
__device__ __forceinline__ int selflag(unsigned k, unsigned prefix, int idx, int Y) { int f; unsigned thr;
    asm volatile("v_cmp_ge_u32 vcc, %2, %3\n\tv_addc_co_u32 %1, vcc, 0, %4, vcc\n\tv_cmp_ge_u32 vcc, %5, %1\n\tv_cndmask_b32 %0, 0, 1, vcc" : "=v"(f), "=&v"(thr) : "v"(idx), "v"(Y), "v"(prefix), "v"(k) : "vcc"); return f; }
__device__ __forceinline__ void cnt_ge4(int& c0, int& c1, unsigned k0, unsigned k1, unsigned k2, unsigned k3, unsigned x) {
    asm volatile("v_cmp_ge_u32 vcc, %2, %6\n\tv_addc_co_u32 %0, vcc, 0, %0, vcc\n\tv_cmp_ge_u32 vcc, %3, %6\n\tv_addc_co_u32 %1, vcc, 0, %1, vcc\n\t"
                 "v_cmp_ge_u32 vcc, %4, %6\n\tv_addc_co_u32 %0, vcc, 0, %0, vcc\n\tv_cmp_ge_u32 vcc, %5, %6\n\tv_addc_co_u32 %1, vcc, 0, %1, vcc"
                 : "+v"(c0), "+v"(c1) : "v"(k0), "v"(k1), "v"(k2), "v"(k3), "v"(x) : "vcc"); }
__device__ __forceinline__ int inband(unsigned k, unsigned prefix) { int f; unsigned d;
    asm volatile("v_sub_u32 %1, %2, %3\n\tv_cmp_gt_u32 vcc, %4, %1\n\tv_cndmask_b32 %0, 0, 1, vcc" : "=v"(f), "=&v"(d) : "v"(k), "v"(prefix), "v"(0x100000u) : "vcc"); return f; }
__device__ __forceinline__ int wtot_dpp(int c) {
    c += __builtin_amdgcn_update_dpp(0, c, 0x128, 0xf, 0xf, false); c += __builtin_amdgcn_update_dpp(0, c, 0x124, 0xf, 0xf, false);
    c += __builtin_amdgcn_update_dpp(0, c, 0x122, 0xf, 0xf, false); c += __builtin_amdgcn_update_dpp(0, c, 0x121, 0xf, 0xf, false);
    return __builtin_amdgcn_readlane(c, 0) + __builtin_amdgcn_readlane(c, 16) + __builtin_amdgcn_readlane(c, 32) + __builtin_amdgcn_readlane(c, 48); }
__device__ __forceinline__ int geflag(unsigned k, unsigned x) { int f; asm volatile("v_cmp_ge_u32 vcc, %1, %2\n\tv_cndmask_b32 %0, 0, 1, vcc" : "=v"(f) : "v"(k), "v"(x) : "vcc"); return f; }
template <int NB> __device__ __forceinline__ int wtotb(int c) { int t = 0;
#pragma unroll
    for (int b = 0; b < NB; ++b) t += (int)__popcll(__builtin_amdgcn_ballot_w64(((c >> b) & 1) != 0)) << b;
    return t; }
__device__ __forceinline__ int wexcl(int c, int lane) { int x = c;
    x += __builtin_amdgcn_update_dpp(0, x, 0x111, 0xf, 0xf, true); x += __builtin_amdgcn_update_dpp(0, x, 0x112, 0xf, 0xf, true);
    x += __builtin_amdgcn_update_dpp(0, x, 0x114, 0xf, 0xf, true); x += __builtin_amdgcn_update_dpp(0, x, 0x118, 0xf, 0xf, true);
    const int r0 = __builtin_amdgcn_readlane(x, 15), r1 = __builtin_amdgcn_readlane(x, 31), r2 = __builtin_amdgcn_readlane(x, 47);
    const int row = lane >> 4; const int add = (row > 0 ? r0 : 0) + (row > 1 ? r1 : 0) + (row > 2 ? r2 : 0);
    return x + add - c; }
__device__ __forceinline__ unsigned mbcnt(unsigned long long m) { return __builtin_amdgcn_mbcnt_hi((unsigned)(m >> 32), __builtin_amdgcn_mbcnt_lo((unsigned)m, 0u)); }

constexpr int REP_SCORE = 1, REP_SELECT = 1;
constexpr int REP_P1 = 1, REP_P2 = 1, REP_FIN = 1;
constexpr int TQ_OFF = 0;
constexpr int TT_OFF = 32768, TT_ROW = 68, TT_WAVE = 32 * TT_ROW * 4;
constexpr int TS_OFF = TT_OFF + 8 * TT_WAVE, TS_WAVE = 1792;
constexpr int TW_OFF = TS_OFF + 8 * TS_WAVE;
constexpr int TOPK_LDS_BYTES = TW_OFF + 1024;

__device__ __forceinline__ void topk_unit(int b, int j, const bf16* IDXP, float* scr, unsigned short* SEL, LAS unsigned char* shm) {
    int tid_ = threadIdx.x; asm volatile("" : "+v"(tid_));
    const int tid = tid_, lane = tid & 63, r32 = lane & 31, hi = lane >> 5; const int wid = __builtin_amdgcn_readfirstlane(tid >> 6);
    const size_t rowbase = (size_t)b * SEQ; const int t0 = 32 * j;
#pragma unroll
    for (int k = 0; k < 4; ++k) { const int c = tid + 512 * k, row = c >> 6, c16 = c & 63;
        const u32x4 v = *(const u32x4*)(IDXP + (rowbase + t0 + row) * NA + IA_QI + c16 * 8);
        *(LAS u32x4*)(shm + TQ_OFF + (((c16 >> 3) * 8 + (c16 & 7)) * 32 + row) * 16) = v; }
    if (tid < 256) { const int q = tid >> 3, hh = tid & 7;
        ((LAS float*)(shm + TW_OFF))[hh * 32 + q] = blo((unsigned)IDXP[(rowbase + t0 + q) * NA + IA_WI + hh]); }
    __syncthreads();
    const int ntiles = (t0 + 32 + 63) >> 6;
    LAS float* tt = (LAS float*)(shm + TT_OFF + wid * TT_WAVE);
    for (int rs_ = 0; rs_ < REP_SCORE; ++rs_) {
    bf16x8 kn[4][2];
#define KF_LOAD(dst, kt_) do { const bf16* kp_ = IDXP + (rowbase + 64 * (kt_) + r32) * NA + IA_KI + 8 * hi; \
        _Pragma("unroll") for (int d0 = 0; d0 < 4; ++d0) { dst[d0][0] = *(const bf16x8*)(kp_ + 16 * d0); dst[d0][1] = *(const bf16x8*)(kp_ + (size_t)32 * NA + 16 * d0); } } while (0)
    if (wid < ntiles) KF_LOAD(kn, wid);
#pragma unroll 1
    for (int kt = wid; kt < ntiles; kt += 8) {
        bf16x8 kf[4][2];
#pragma unroll
        for (int d0 = 0; d0 < 4; ++d0) { kf[d0][0] = kn[d0][0]; kf[d0][1] = kn[d0][1]; }
        if (kt + 8 < ntiles) KF_LOAD(kn, kt + 8);
        f32x16 s0 = f32x16{}, s1 = f32x16{};
#pragma unroll 2
        for (int h = 0; h < 8; ++h) {
            const float wh = ((const LAS float*)(shm + TW_OFF))[h * 32 + r32];
            bf16x8 qf[4];
#pragma unroll
            for (int d0 = 0; d0 < 4; ++d0) qf[d0] = *(const LAS bf16x8*)(shm + TQ_OFF + ((h * 8 + 2 * d0 + hi) * 32 + r32) * 16);
            { f32x16 p = f32x16{};
#pragma unroll
              for (int d0 = 0; d0 < 4; ++d0) p = __builtin_amdgcn_mfma_f32_32x32x16_bf16(kf[d0][0], qf[d0], p, 0, 0, 0);
#pragma unroll
              for (int r = 0; r < 16; ++r) s0[r] += wh * fmaxf(p[r], 0.f); }
            { f32x16 p = f32x16{};
#pragma unroll
              for (int d0 = 0; d0 < 4; ++d0) p = __builtin_amdgcn_mfma_f32_32x32x16_bf16(kf[d0][1], qf[d0], p, 0, 0, 0);
#pragma unroll
              for (int r = 0; r < 16; ++r) s1[r] += wh * fmaxf(p[r], 0.f); }
        }
#pragma unroll
        for (int g = 0; g < 4; ++g) {
            *(LAS f32x4*)(tt + r32 * TT_ROW + 8 * g + 4 * hi) = (f32x4){s0[4 * g], s0[4 * g + 1], s0[4 * g + 2], s0[4 * g + 3]};
            *(LAS f32x4*)(tt + r32 * TT_ROW + 32 + 8 * g + 4 * hi) = (f32x4){s1[4 * g], s1[4 * g + 1], s1[4 * g + 2], s1[4 * g + 3]}; }
        asm volatile("s_waitcnt lgkmcnt(0)" ::: "memory");
#pragma unroll
        for (int i = 0; i < 8; ++i) { const int row = 4 * i + (lane >> 4), col = (lane & 15) * 4;
            const f32x4 v = *(const LAS f32x4*)(tt + row * TT_ROW + col);
            *(f32x4*)(scr + (size_t)row * 4096 + 64 * kt + col) = v; }
        asm volatile("s_waitcnt lgkmcnt(0)" ::: "memory");
    }
    }
#undef KF_LOAD
    asm volatile("s_waitcnt vmcnt(0)" ::: "memory");
    __syncthreads();
    LAS unsigned short* sl = (LAS unsigned short*)(shm + TS_OFF + wid * TS_WAVE);
    LAS unsigned* bk = (LAS unsigned*)(shm + TS_OFF + wid * TS_WAVE + 640); LAS unsigned short* bi = (LAS unsigned short*)(shm + TS_OFF + wid * TS_WAVE + 640 + 768);
    LAS unsigned char* rowbuf = shm + wid * 12800;
#define ROW_DMA(qq) do { const int n_ = t0 + (qq) + 1; const int ni_ = (n_ + 255) >> 8; const float* sr_ = scr + (size_t)(qq) * 4096 + 4 * lane; \
        if (n_ > 256) { _Pragma("unroll") for (int g_ = 0; g_ < 12; ++g_) if (g_ < ni_) __builtin_amdgcn_global_load_lds((const unsigned*)(sr_ + 256 * g_), (LAS unsigned*)(rowbuf + 1024 * g_), 16, 0, 0); } } while (0)
    for (int rq_ = 0; rq_ < REP_SELECT; ++rq_) {
    ROW_DMA(wid);
#pragma unroll 1
    for (int qi = wid; qi < 32; qi += 8) {
        const int t = t0 + qi, n = t + 1;
        unsigned short* selrow = SEL + (rowbase + t) * 256;
        if (n <= 256) { const unsigned a = 4 * lane; *(u32x2*)(selrow + a) = (u32x2){a | ((a + 1) << 16), (a + 2) | ((a + 3) << 16)}; if (qi + 8 < 32) ROW_DMA(qi + 8); continue; }
        unsigned k[64];
        const int ni = (n + 255) >> 8;
#define FOR_VALID(i) _Pragma("unroll") for (int i = 0; i < 16; ++i) if (i < ni)
        { f32x4 late[4];
          if (ni > 12) {
#pragma unroll
              for (int g = 0; g < 4; ++g) late[g] = *(const f32x4*)(scr + (size_t)qi * 4096 + 4 * lane + 256 * (12 + g)); }
          asm volatile("s_waitcnt vmcnt(0)" ::: "memory");
#pragma unroll
          for (int i = 0; i < 16; ++i) {
              if (i < ni) { const f32x4 v = (i < 12) ? *(const LAS f32x4*)(rowbuf + 1024 * (i < 12 ? i : 0) + 16 * lane) : late[i < 12 ? 0 : i - 12];
#pragma unroll
                  for (int e = 0; e < 4; ++e) k[4 * i + e] = (256 * i + 4 * lane + e < n) ? f2key(v[e]) : 0u; }
              else {
#pragma unroll
                  for (int e = 0; e < 4; ++e) k[4 * i + e] = 0u; } }
          asm volatile("s_waitcnt lgkmcnt(0)" ::: "memory"); }
        if (qi + 8 < 32) ROW_DMA(qi + 8);
        const int l4 = 4 * lane;
        typedef short s16x2 __attribute__((ext_vector_type(2)));
        s16x2 kk[32];
#pragma unroll
        for (int j = 0; j < 32; ++j) { const unsigned pk = __builtin_amdgcn_perm(k[2 * j + 1], k[2 * j], 0x07060302u);
            kk[j] = __builtin_bit_cast(s16x2, (pk >> 1) & 0x7fff7fffu); }
        unsigned prefix = 0u;
        for (int rp1_ = 0; rp1_ < REP_P1; ++rp1_) { prefix = 0u; asm volatile("" : "+s"(prefix));
        for (int bit = 31; bit >= 20; --bit) {
            const unsigned cand = prefix | (1u << bit); const unsigned c15 = cand >> 17; const s16x2 cc = __builtin_bit_cast(s16x2, c15 | (c15 << 16));
            s16x2 a0 = (s16x2){0, 0}, a1 = (s16x2){0, 0};
#pragma unroll
            for (int j = 0; j < 32; j += 2) { a0 += (kk[j] - cc) >> 15; a1 += (kk[j + 1] - cc) >> 15; }
            const s16x2 a = a0 + a1; const int clt = -((int)a.x + (int)a.y);
            if (4096 - wtot_dpp(clt) >= 256) prefix = cand;
        } }
        const unsigned hiB = (prefix + (1u << 20) < prefix) ? 0xffffffffu : prefix + (1u << 20);
        int ca = 0, cb = 0;
        { int ca1 = 0, cb1 = 0;
          FOR_VALID(i) { cnt_ge4(ca, ca1, k[4 * i], k[4 * i + 1], k[4 * i + 2], k[4 * i + 3], hiB); cnt_ge4(cb, cb1, k[4 * i], k[4 * i + 1], k[4 * i + 2], k[4 * i + 3], prefix); }
          ca += ca1; cb += cb1; }
        const int above = wtot_dpp(ca), nb = wtot_dpp(cb) - above;
        int Y = 4096;
        if (nb <= 128) {
            int pos = wexcl(cb - ca, lane); const int dummy = 128 + lane;
            FOR_VALID(i) {
#pragma unroll
                for (int e = 0; e < 4; ++e) { const int f = inband(k[4 * i + e], prefix); const int ad = dummy + f * (pos - dummy);
                    bk[ad] = k[4 * i + e]; bi[ad] = (unsigned short)((256 * i + e) | l4); pos += f; } }
            asm volatile("s_waitcnt lgkmcnt(0)" ::: "memory");
            const unsigned kb0 = (lane < nb) ? bk[lane] : 0u, kb1 = (64 + lane < nb) ? bk[64 + lane] : 0u;
            const int ib0 = bi[lane], ib1 = bi[64 + lane];
            const unsigned p12_ = prefix;
            for (int rp2_ = 0; rp2_ < REP_P2; ++rp2_) { prefix = p12_; asm volatile("" : "+s"(prefix));
            for (int bit = 19; bit >= 0; --bit) {
                const unsigned cand = prefix | (1u << bit); int c = 0; cnt_ge(c, kb0, cand); cnt_ge(c, kb1, cand);
                if (above + wtot_dpp(c) >= 256) prefix = cand;
            } }
            int cg = 0, cge = 0; cnt_ge(cg, kb0, prefix + 1u); cnt_ge(cg, kb1, prefix + 1u); cnt_ge(cge, kb0, prefix); cnt_ge(cge, kb1, prefix);
            const int ngt = above + wtot_dpp(cg), neq = above + wtot_dpp(cge) - ngt, need = 256 - ngt;
            if (neq != need) { Y = 0;
                for (int bit = 12; bit >= 0; --bit) { const int cand = Y | (1 << bit); const int c = selflag(kb0, prefix, ib0, cand) + selflag(kb1, prefix, ib1, cand);
                    if (above + wtot_dpp(c) - ngt <= need) Y = cand; } }
            asm volatile("s_waitcnt lgkmcnt(0)" ::: "memory");
        } else {
            for (int bit = 19; bit >= 0; --bit) {
                const unsigned cand = prefix | (1u << bit); int c = 0;
                FOR_VALID(i) { cnt_ge(c, k[4 * i], cand); cnt_ge(c, k[4 * i + 1], cand); cnt_ge(c, k[4 * i + 2], cand); cnt_ge(c, k[4 * i + 3], cand); }
                if (wtotb<7>(c) >= 256) prefix = cand;
            }
            int cg = 0, cge = 0;
            FOR_VALID(i) {
#pragma unroll
                for (int e = 0; e < 4; ++e) { cnt_ge(cg, k[4 * i + e], prefix + 1u); cnt_ge(cge, k[4 * i + e], prefix); } }
            const int ngt = wtotb<7>(cg), neq = wtotb<7>(cge) - ngt, need = 256 - ngt;
            if (neq != need) { Y = 0;
                for (int bit = 12; bit >= 0; --bit) { const int cand = Y | (1 << bit); int c = 0;
                    FOR_VALID(i) {
#pragma unroll
                        for (int e = 0; e < 4; ++e) c += selflag(k[4 * i + e], prefix, (256 * i + e) | l4, cand); }
                    if (wtotb<7>(c) - ngt <= need) Y = cand; } }
        }
        for (int rf_ = 0; rf_ < REP_FIN; ++rf_) {
        int cs = 0;
        FOR_VALID(i) {
#pragma unroll
            for (int e = 0; e < 4; ++e) cs += selflag(k[4 * i + e], prefix, (256 * i + e) | l4, Y); }
        { int pos = wexcl(cs, lane); const int dummy = 256 + lane;
          FOR_VALID(i) {
#pragma unroll
              for (int e = 0; e < 4; ++e) { const int idx = (256 * i + e) | l4; const int f = selflag(k[4 * i + e], prefix, idx, Y);
                  sl[dummy + f * (pos - dummy)] = (unsigned short)idx; pos += f; } } }
        }
#undef FOR_VALID
        asm volatile("s_waitcnt lgkmcnt(0)" ::: "memory");
        *(u32x2*)(selrow + 4 * lane) = *(const LAS u32x2*)(sl + 4 * lane);
        asm volatile("s_waitcnt lgkmcnt(0)" ::: "memory");
    }
    }
#undef ROW_DMA
    asm volatile("s_waitcnt vmcnt(0)" ::: "memory");
    __syncthreads();
}
__device__ __forceinline__ void kdn_rows(const bf16* IDXP, const float* gk, bf16* KDN, int row0, int nrows, int tid) {
    asm volatile("" : "+v"(tid));
    const int lane = tid & 63, wid = tid >> 6;
    for (int r = wid * 8 + (lane >> 3); r < nrows; r += 64) {
        const int row = row0 + r, ch = lane & 7;
        const u32x4 v = *(const u32x4*)(IDXP + (size_t)row * NA + IA_KD + 8 * ch);
        float x[8] = {blo(v.x), bhi(v.x), blo(v.y), bhi(v.y), blo(v.z), bhi(v.z), blo(v.w), bhi(v.w)};
        float ss = 0.f;
#pragma unroll
        for (int e = 0; e < 8; ++e) ss += x[e] * x[e];
        ss += __shfl_xor(ss, 1); ss += __shfl_xor(ss, 2); ss += __shfl_xor(ss, 4);
        const float inv = 1.0f / sqrtf(ss * (1.f / 64.f) + RMS_EPS);
        const f32x4 g0 = *(const f32x4*)(gk + 8 * ch), g1 = *(const f32x4*)(gk + 8 * ch + 4);
        u32x4 o; o.x = cvtpk(x[0] * inv * g0[0], x[1] * inv * g0[1]); o.y = cvtpk(x[2] * inv * g0[2], x[3] * inv * g0[3]); o.z = cvtpk(x[4] * inv * g1[0], x[5] * inv * g1[1]); o.w = cvtpk(x[6] * inv * g1[2], x[7] * inv * g1[3]);
        *(u32x4*)(KDN + (size_t)row * 64 + 8 * ch) = o;
    }
}
__device__ __forceinline__ void topk_phase(const bf16* IDXP, const float* gk, float* scores, unsigned short* SEL, bf16* KDN, LAS unsigned char* shm, int vcu, int G) {
    for (int v = vcu; v < 256; v += G) {
        kdn_rows(IDXP, gk, KDN, v * 64, 64, threadIdx.x);
        float* scr = scores + (size_t)v * 32 * 4096;
        const int b = v >> 6, j = v & 63;
        topk_unit(b, j, IDXP, scr, SEL, shm);
        topk_unit(b, 127 - j, IDXP, scr, SEL, shm);
    }
}

constexpr int AV_ROW = 160, AV_SLOTS = 32, AQ_BYTES = 512 + AV_SLOTS * AV_ROW, AW_BYTES = 2 * AQ_BYTES;
constexpr int ATT_LDS_BYTES = 8 * AW_BYTES;
__device__ __forceinline__ s16x4 vtr(const LAS unsigned char* p) { return __builtin_bit_cast(s16x4, __builtin_amdgcn_ds_read_tr16_b64_v4i16((LAS v4i16_t*)p)); }
__device__ __forceinline__ void dsa_query2(int m0, const bf16* P2, const bf16* IDXP, const bf16* KDN, const unsigned short* SEL, const float* gq, bf16* YD, LAS unsigned char* wl, int lane) {
    asm volatile("" : "+v"(lane));
    const int h16 = lane & 15, dq = lane >> 4;
    int mm[2], tt[2], ns[2]; size_t rb[2];
#pragma unroll
    for (int q = 0; q < 2; ++q) { mm[q] = m0 + q; const int b = mm[q] / SEQ; tt[q] = mm[q] - b * SEQ; rb[q] = (size_t)b * SEQ; ns[q] = (tt[q] + 1 < 256) ? tt[q] + 1 : 256; }
#pragma unroll
    for (int q = 0; q < 2; ++q) { u32x2 v = *(const u32x2*)(SEL + (size_t)mm[q] * 256 + 4 * lane); const int nsel = ns[q];
        if (4 * lane + 0 >= nsel) v.x &= 0xffff0000u; if (4 * lane + 1 >= nsel) v.x &= 0x0000ffffu; if (4 * lane + 2 >= nsel) v.y &= 0xffff0000u; if (4 * lane + 3 >= nsel) v.y &= 0x0000ffffu;
        *(LAS u32x2*)(wl + q * AQ_BYTES + 8 * lane) = v; }
    bf16x8 qf[2][2];
    const f32x4 g0 = *(const f32x4*)(gq + 8 * dq), g1 = *(const f32x4*)(gq + 8 * dq + 4), g2 = *(const f32x4*)(gq + 32 + 8 * dq), g3 = *(const f32x4*)(gq + 32 + 8 * dq + 4);
#pragma unroll
    for (int q = 0; q < 2; ++q) { float x[16];
      if (h16 < 8) {
          const u32x4 v0 = *(const u32x4*)(P2 + (size_t)mm[q] * 2048 + PB_QD + 64 * h16 + 8 * dq), v1 = *(const u32x4*)(P2 + (size_t)mm[q] * 2048 + PB_QD + 64 * h16 + 32 + 8 * dq);
          x[0] = blo(v0.x); x[1] = bhi(v0.x); x[2] = blo(v0.y); x[3] = bhi(v0.y); x[4] = blo(v0.z); x[5] = bhi(v0.z); x[6] = blo(v0.w); x[7] = bhi(v0.w);
          x[8] = blo(v1.x); x[9] = bhi(v1.x); x[10] = blo(v1.y); x[11] = bhi(v1.y); x[12] = blo(v1.z); x[13] = bhi(v1.z); x[14] = blo(v1.w); x[15] = bhi(v1.w);
      } else {
#pragma unroll
          for (int e = 0; e < 16; ++e) x[e] = 0.f; }
      float ss = 0.f;
#pragma unroll
      for (int e = 0; e < 16; ++e) ss += x[e] * x[e];
      ss += __shfl_xor(ss, 16); ss += __shfl_xor(ss, 32);
      const float inv = (1.0f / sqrtf(ss * (1.f / 64.f) + RMS_EPS)) * (0.125f * 1.4426950408889634f);
      u32x4 w0, w1;
      w0.x = cvtpk(x[0] * inv * g0[0], x[1] * inv * g0[1]); w0.y = cvtpk(x[2] * inv * g0[2], x[3] * inv * g0[3]); w0.z = cvtpk(x[4] * inv * g1[0], x[5] * inv * g1[1]); w0.w = cvtpk(x[6] * inv * g1[2], x[7] * inv * g1[3]);
      w1.x = cvtpk(x[8] * inv * g2[0], x[9] * inv * g2[1]); w1.y = cvtpk(x[10] * inv * g2[2], x[11] * inv * g2[3]); w1.z = cvtpk(x[12] * inv * g3[0], x[13] * inv * g3[1]); w1.w = cvtpk(x[14] * inv * g3[2], x[15] * inv * g3[3]);
      qf[q][0] = __builtin_bit_cast(bf16x8, w0); qf[q][1] = __builtin_bit_cast(bf16x8, w1); }
    asm volatile("s_waitcnt lgkmcnt(0)" ::: "memory");
    f32x4 acc[2][16];
#pragma unroll
    for (int g = 0; g < 16; ++g)
#pragma unroll
        for (int q = 0; q < 2; ++q) { const int kidx = ((const LAS unsigned short*)(wl + q * AQ_BYTES))[16 * g + h16];
            const bf16* kr = KDN + (rb[q] + kidx) * 64 + 8 * dq;
            const bf16x8 a0 = *(const bf16x8*)kr, a1 = *(const bf16x8*)(kr + 32);
            f32x4 c = (f32x4){0.f, 0.f, 0.f, 0.f};
            c = __builtin_amdgcn_mfma_f32_16x16x32_bf16(a0, qf[q][0], c, 0, 0, 0); c = __builtin_amdgcn_mfma_f32_16x16x32_bf16(a1, qf[q][1], c, 0, 0, 0); acc[q][g] = c; }
    const float slope2 = __builtin_amdgcn_exp2f(-(float)((h16 & 7) + 1)) * 1.4426950408889634f;
    u32x4 pw[2][8];
#pragma unroll
    for (int q = 0; q < 2; ++q) { float mx = -INFINITY; const LAS unsigned short* sl = (const LAS unsigned short*)(wl + q * AQ_BYTES); const int t = tt[q], nsel = ns[q];
#pragma unroll
        for (int g = 0; g < 16; ++g) { const u32x2 kk = *(const LAS u32x2*)(sl + 16 * g + 4 * dq);
            const int kp[4] = {(int)(kk.x & 0xffffu), (int)(kk.x >> 16), (int)(kk.y & 0xffffu), (int)(kk.y >> 16)};
#pragma unroll
            for (int r = 0; r < 4; ++r) { const int slot = 16 * g + 4 * dq + r; float v = acc[q][g][r] - slope2 * (float)(t - kp[r]); v = (slot < nsel) ? v : -INFINITY; acc[q][g][r] = v; mx = fmaxf(mx, v); } }
        mx = fmaxf(mx, __shfl_xor(mx, 16)); mx = fmaxf(mx, __shfl_xor(mx, 32));
        float sum = 0.f;
#pragma unroll
        for (int g = 0; g < 16; ++g)
#pragma unroll
            for (int r = 0; r < 4; ++r) { const float p = __builtin_amdgcn_exp2f(acc[q][g][r] - mx); acc[q][g][r] = p; sum += p; }
        sum += __shfl_xor(sum, 16); sum += __shfl_xor(sum, 32);
        const float r_ = 1.0f / sum;
#pragma unroll
        for (int c = 0; c < 8; ++c) { const int g0 = 2 * c;
            pw[q][c].x = cvtpk(acc[q][g0][0] * r_, acc[q][g0][1] * r_); pw[q][c].y = cvtpk(acc[q][g0][2] * r_, acc[q][g0][3] * r_); pw[q][c].z = cvtpk(acc[q][g0 + 1][0] * r_, acc[q][g0 + 1][1] * r_); pw[q][c].w = cvtpk(acc[q][g0 + 1][2] * r_, acc[q][g0 + 1][3] * r_); } }
    f32x4 o[2][4];
#pragma unroll
    for (int q = 0; q < 2; ++q)
#pragma unroll
        for (int d = 0; d < 4; ++d) o[q][d] = (f32x4){0.f, 0.f, 0.f, 0.f};
#pragma unroll
    for (int c = 0; c < 8; ++c) {
        u32x4 vr[2][4];
#pragma unroll
        for (int q = 0; q < 2; ++q)
#pragma unroll
            for (int i = 0; i < 4; ++i) { const int slot = (lane >> 3) + 8 * i, part = lane & 7; const int kidx = ((const LAS unsigned short*)(wl + q * AQ_BYTES))[32 * c + slot];
                vr[q][i] = *(const u32x4*)(IDXP + (rb[q] + kidx) * NA + IA_VD + 8 * part); }
#pragma unroll
        for (int q = 0; q < 2; ++q)
#pragma unroll
            for (int i = 0; i < 4; ++i) { const int slot = (lane >> 3) + 8 * i, part = lane & 7; *(LAS u32x4*)(wl + q * AQ_BYTES + 512 + slot * AV_ROW + part * 16) = vr[q][i]; }
        asm volatile("s_waitcnt lgkmcnt(0)" ::: "memory");
#pragma unroll
        for (int q = 0; q < 2; ++q) {
            const LAS unsigned char* vb = wl + q * AQ_BYTES + 512 + (4 * dq + ((lane & 15) >> 2)) * AV_ROW + (lane & 3) * 8;
#pragma unroll
            for (int d = 0; d < 4; ++d) { const s16x4 lo = vtr(vb + d * 32), hh = vtr(vb + 16 * AV_ROW + d * 32);
                const bf16x8 vf = (bf16x8){lo[0], lo[1], lo[2], lo[3], hh[0], hh[1], hh[2], hh[3]};
                o[q][d] = __builtin_amdgcn_mfma_f32_16x16x32_bf16(__builtin_bit_cast(bf16x8, pw[q][c]), vf, o[q][d], 0, 0, 0); } }
        asm volatile("s_waitcnt lgkmcnt(0)" ::: "memory");
    }
    if (dq < 2) {
#pragma unroll
        for (int q = 0; q < 2; ++q)
#pragma unroll
            for (int d = 0; d < 4; ++d)
#pragma unroll
                for (int r = 0; r < 4; ++r) YD[(size_t)mm[q] * 512 + (4 * dq + r) * 64 + 16 * d + h16] = (bf16)f2bf(o[q][d][r]);
    }
}
__device__ __forceinline__ void dsa_att_phase(const bf16* P2, const bf16* IDXP, const bf16* KDN, const unsigned short* SEL, const float* gq, bf16* YD, LAS unsigned char* shm, int vcu, int G) {
    const int lane = threadIdx.x & 63; const int wid = __builtin_amdgcn_readfirstlane(threadIdx.x >> 6);
    LAS unsigned char* wl = shm + wid * AW_BYTES;
    for (int m = (vcu * 8 + wid) * 2; m < M; m += G * 16) dsa_query2(m, P2, IDXP, KDN, SEL, gq, YD, wl, lane);
}
}
struct Frame {
    LAS unsigned char* lds;
    volatile LAS unsigned* MISC;
    gu32* ctl;
    int tid, lane, wave, vcu, G;
    unsigned char* ws;
    const float* in[21]; float* out;
};
enum { I_X = 0, I_C, I_WADA, I_BADA, I_GFFN1, I_W1A, I_W3A, I_W2A, I_GMIX, I_WIN, I_GQ, I_GK, I_WPSB, I_WPD, I_WGATE, I_BGATE, I_WOUT, I_GFFN2, I_W1B, I_W3B, I_W2B };

__device__ __forceinline__ float wave_sum(float v) {
#pragma unroll
    for (int o = 1; o < 64; o <<= 1) v += __shfl_xor(v, o);
    return v;
}
__device__ __forceinline__ void tr_item(const float* W, int ldw, int c0, int nvalid, int k0, bf16* WT, int K, int drow0, LAS float* scr, int lane) {
    const int n = lane & 31;
#pragma unroll 8
    for (int i = 0; i < 32; ++i) { const int kk = 2 * i + (lane >> 5); scr[kk * 33 + n] = (n < nvalid) ? W[(size_t)(k0 + kk) * ldw + c0 + n] : 0.f; }
    LDS_WAIT(); asm volatile("" ::: "memory");
    const int c = lane & 7;
#pragma unroll
    for (int j = 0; j < 4; ++j) { const int nn = (lane >> 3) + 8 * j; const LAS float* s = scr + (8 * c) * 33 + nn;
        v4u o; o.x = pk2(s[0 * 33], s[1 * 33]); o.y = pk2(s[2 * 33], s[3 * 33]); o.z = pk2(s[4 * 33], s[5 * 33]); o.w = pk2(s[6 * 33], s[7 * 33]);
        *(GAS v4u*)(WT + (size_t)(drow0 + nn) * K + k0 + 8 * c) = o; }
    LDS_WAIT(); asm volatile("" ::: "memory");
}
__device__ __forceinline__ bool tr_seg(int& r, const float* W, int ldw, int K, int c0, int ncb, int nvalid_last, bf16* WT, int drow0, int kind, LAS float* scr, int lane) {
    const int items = (K / 64) * ncb;
    if (r >= items) { r -= items; return false; }
    const int kb = r / ncb, cb = r % ncb, col = c0 + 32 * cb;
    const int nvalid = (cb == ncb - 1) ? nvalid_last : 32;
    int drow;
    if (kind == 0) drow = drow0 + 32 * cb; else drow = 256 * (col / 128) + (col % 128) + (kind == 2 ? 128 : 0);
    tr_item(W, ldw, col, nvalid, 64 * kb, WT, K, drow, scr, lane);
    return true;
}
__device__ __forceinline__ void p0_prologue(Frame& F) {
    LAS float* scr = (LAS float*)(F.lds + RING_OFF + F.wave * 16384);
    const int gw = F.vcu * NWAVES + F.wave, NGW = F.G * NWAVES;
    bf16* W13_1 = (bf16*)(F.ws + WS_W13_1); bf16* W2_1 = (bf16*)(F.ws + WS_W2_1); bf16* W13_2 = (bf16*)(F.ws + WS_W13_2); bf16* W2_2 = (bf16*)(F.ws + WS_W2_2);
    bf16* WA = (bf16*)(F.ws + WS_WA); bf16* WB = (bf16*)(F.ws + WS_WB); bf16* WPSB = (bf16*)(F.ws + WS_WPSB); bf16* WPD = (bf16*)(F.ws + WS_WPD); bf16* WOUT = (bf16*)(F.ws + WS_WOUT);
    constexpr int NITEMS = 6 * 1408 + 1024 + 1024 + 288 + 16 + 16 + 64 + 256 + 256 + 512;
    for (int it = gw; it < NITEMS; it += NGW) {
        int r = it;
        if (tr_seg(r, F.in[I_W1A], FF, D, 0, 88, 32, W13_1, 0, 1, scr, F.lane)) continue;
        if (tr_seg(r, F.in[I_W3A], FF, D, 0, 88, 32, W13_1, 0, 2, scr, F.lane)) continue;
        if (tr_seg(r, F.in[I_W2A], D, FF, 0, 32, 32, W2_1, 0, 0, scr, F.lane)) continue;
        if (tr_seg(r, F.in[I_W1B], FF, D, 0, 88, 32, W13_2, 0, 1, scr, F.lane)) continue;
        if (tr_seg(r, F.in[I_W3B], FF, D, 0, 88, 32, W13_2, 0, 2, scr, F.lane)) continue;
        if (tr_seg(r, F.in[I_W2B], D, FF, 0, 32, 32, W2_2, 0, 0, scr, F.lane)) continue;
        if (tr_seg(r, F.in[I_WIN], DIN, D, 0, 64, 32, WB, 0, 0, scr, F.lane)) continue;
        if (tr_seg(r, F.in[I_WGATE], 2048, D, 0, 64, 32, WB, 2048, 0, scr, F.lane)) continue;
        if (tr_seg(r, F.in[I_WIN], DIN, D, 2176, 18, 32, WA, 0, 0, scr, F.lane)) continue;
        if (tr_seg(r, F.in[I_WIN], DIN, D, 2752, 1, 8, WA, 576, 0, scr, F.lane)) continue;
        if (tr_seg(r, F.in[I_WIN], DIN, D, 0, 1, 0, WA, 608, 0, scr, F.lane)) continue;
        if (tr_seg(r, F.in[I_WIN], DIN, D, 2048, 4, 32, WA, 640, 0, scr, F.lane)) continue;
        if (tr_seg(r, F.in[I_WPSB], D, 512, 0, 32, 32, WPSB, 0, 0, scr, F.lane)) continue;
        if (tr_seg(r, F.in[I_WPD], D, 512, 0, 32, 32, WPD, 0, 0, scr, F.lane)) continue;
        tr_seg(r, F.in[I_WOUT], D, D, 0, 32, 32, WOUT, 0, 0, scr, F.lane);
    }
    __syncthreads();
    LAS float* sc = (LAS float*)(F.lds + RING_OFF);
    LAS float* red = (LAS float*)(F.lds + RING_OFF + 16384);
    for (int i = F.tid; i < 4096; i += NWAVES * 64) { const float v = F.in[I_C][i]; sc[i] = v / (1.f + __expf(-v)); }
    __syncthreads();
    float* MOD = (float*)(F.ws + WS_MOD);
    for (int sl = F.vcu; sl < 256; sl += F.G) {
        const int cq = F.tid % 9, rg = F.tid / 9;
        if (rg < 56) {
            float a[4][4];
#pragma unroll
            for (int b = 0; b < 4; ++b)
#pragma unroll
                for (int e = 0; e < 4; ++e) a[b][e] = 0.f;
            for (int k = rg; k < 1024; k += 56) { const f32x4 w = *(const GAS f32x4*)(F.in[I_WADA] + (size_t)k * NMOD + 36 * sl + 4 * cq);
#pragma unroll
                for (int b = 0; b < 4; ++b) { const float s = sc[b * 1024 + k];
#pragma unroll
                    for (int e = 0; e < 4; ++e) a[b][e] += s * w[e]; } }
#pragma unroll
            for (int b = 0; b < 4; ++b)
#pragma unroll
                for (int e = 0; e < 4; ++e) red[(rg * 9 + cq) * 16 + b * 4 + e] = a[b][e];
        }
        __syncthreads();
        if (F.tid < 144) { const int b = F.tid / 36, j = F.tid % 36, cq = j >> 2, e = j & 3; float s = 0.f;
            for (int g = 0; g < 56; ++g) s += red[(g * 9 + cq) * 16 + b * 4 + e];
            MOD[b * NMOD + 36 * sl + j] = s + F.in[I_BADA][36 * sl + j]; }
        __syncthreads();
    }
}
__device__ __forceinline__ void norm_phase(Frame& F, const float* xin, const float* g, int shift_chunk, int scale_chunk) {
    const int gw = F.vcu * NWAVES + F.wave, NGW = F.G * NWAVES;
    const float* MOD = (const float*)(F.ws + WS_MOD); bf16* XN = (bf16*)(F.ws + WS_XN);
    for (int m = gw; m < M; m += NGW) {
        const int b = m / SEQ;
        const GAS f32x4* xr = (const GAS f32x4*)(xin + (size_t)m * D) + F.lane;
        const GAS f32x4* gr = (const GAS f32x4*)g + F.lane;
        const GAS f32x4* shr = (const GAS f32x4*)(MOD + (size_t)b * NMOD + shift_chunk * 1024) + F.lane;
        const GAS f32x4* scr = (const GAS f32x4*)(MOD + (size_t)b * NMOD + scale_chunk * 1024) + F.lane;
        f32x4 v[4]; float s = 0.f;
#pragma unroll
        for (int j = 0; j < 4; ++j) { v[j] = xr[64 * j]; s += (v[j].x * v[j].x + v[j].y * v[j].y) + (v[j].z * v[j].z + v[j].w * v[j].w); }
        const float inv = 1.f / sqrtf(wave_sum(s) * (1.f / D) + RMS_EPS);
        GAS unsigned long long* o8 = (GAS unsigned long long*)(XN + (size_t)m * D) + F.lane;
#pragma unroll
        for (int j = 0; j < 4; ++j) { const f32x4 gg = gr[64 * j], sh = shr[64 * j], sc = scr[64 * j];
            const f32x4 y = v[j] * inv * gg * (sc + 1.0f) + sh;
            o8[64 * j] = (unsigned long long)pk2(y.x, y.y) | ((unsigned long long)pk2(y.z, y.w) << 32); }
    }
}

struct Args { const float* in[21]; float* out; unsigned char* ws; int ph_lo, ph_hi, region, pad; };
enum { PH_PRO = 0, PH_NORM1, PH_UP1, PH_DOWN1, PH_NORM2, PH_GA, PH_TOPK, PH_GB, PH_ATT, PH_PSB, PH_PD, PH_WOUT, PH_NORM3, PH_UP2, PH_DOWN2, PH_N };
#define REP_LIST {1,1,1,1,1,1,1,1,1,1,1,1,1,1,1}
constexpr int REP[PH_N] = REP_LIST;
constexpr int EXTRA_BARS = 0;
constexpr int REP_SB = 1, REP_DSA = 1;
constexpr int NPASS = 1;
__global__ void __launch_bounds__(NWAVES * 64, 2) mk_fwd(Args args) {
    extern __shared__ __attribute__((aligned(16))) unsigned char lds[];
    Frame F;
    F.lds = (LAS unsigned char*)lds;
    F.MISC = (volatile LAS unsigned*)(F.lds + MISC_OFF);
    F.tid = threadIdx.x; F.lane = F.tid & 63; F.wave = __builtin_amdgcn_readfirstlane(F.tid >> 6);
    F.G = gridDim.x; { const int bx = blockIdx.x; F.vcu = (F.G % 8 == 0) ? (bx % 8) * (F.G / 8) + bx / 8 : bx; }
    F.ws = args.ws; F.ctl = (gu32*)(args.ws + WS_CTL); F.out = args.out;
#pragma unroll
    for (int i = 0; i < 21; ++i) F.in[i] = args.in[i];
    for (int u = F.tid; u < (LDS_BYTES - LDSCTL_OFF) / 4; u += NWAVES * 64) ((LAS unsigned*)(F.lds + LDSCTL_OFF))[u] = 0u;
    __syncthreads();
    const int lo = args.ph_lo, hi = args.ph_hi;
    XcdBarrier bar = xcd_barrier_post((unsigned*)(F.ctl + CW_BAR) + args.region * XCD_BAR_WORDS, F.MISC + 8);
#define IN(k) (lo <= (k) && (k) < hi)
#define SEAM(k) do { if (IN(k) && IN((k) + 1)) xcd_barrier(bar); } while (0)
    unsigned char* ws = args.ws;
    bf16* XN = (bf16*)(ws + WS_XN); bf16* HB = (bf16*)(ws + WS_HB); const float* MOD = (const float*)(ws + WS_MOD);

    for (int eb_ = 0; eb_ < EXTRA_BARS; ++eb_) xcd_barrier(bar);
    if (IN(PH_PRO)) for (int rep_ = 0; rep_ < REP[PH_PRO]; ++rep_) { p0_prologue(F); } SEAM(PH_PRO);
    if (IN(PH_NORM1)) for (int rep_ = 0; rep_ < REP[PH_NORM1]; ++rep_) { norm_phase(F, F.in[I_X], F.in[I_GFFN1], 0, 1); } SEAM(PH_NORM1);
    if (IN(PH_UP1)) for (int rep_ = 0; rep_ < REP[PH_UP1]; ++rep_) { pg8::Gemm g{XN, (const bf16*)(ws + WS_W13_1), M, 2 * FF, D}; pg8::StaticOrder S; S.init(M, 2 * FF, F.G, (int)blockIdx.x);
        pg8::EpiSwiglu E{HB, FF}; pg8::gemm_phase<pg8::EpiSwiglu, pg8::StaticOrder, true, true>(F.lds + RING_OFF, g, S, E); } SEAM(PH_UP1);
    if (IN(PH_DOWN1)) for (int rep_ = 0; rep_ < REP[PH_DOWN1]; ++rep_) { pg8::Gemm g{HB, (const bf16*)(ws + WS_W2_1), M, D, FF}; pg8::StaticOrder S; S.init(M, D, F.G, (int)blockIdx.x);
        pg8::EpiResid E{F.in[I_X], F.out, MOD, 2, 0.5f}; pg8::gemm_phase<pg8::EpiResid, pg8::StaticOrder, true, true>(F.lds + RING_OFF, g, S, E); } SEAM(PH_DOWN1);
    if (IN(PH_NORM2)) for (int rep_ = 0; rep_ < REP[PH_NORM2]; ++rep_) { norm_phase(F, F.out, F.in[I_GMIX], 3, 4); } SEAM(PH_NORM2);
    if (IN(PH_GA)) for (int rep_ = 0; rep_ < REP[PH_GA]; ++rep_) { pg8::Gemm g{XN, (const bf16*)(ws + WS_WA), M, NA, D}; pg8::StaticOrder S; S.init(M, NA, F.G, (int)blockIdx.x);
        pg8::EpiPlain E{(bf16*)(ws + WS_IDXP), NA}; pg8::gemm_phase<pg8::EpiPlain, pg8::StaticOrder, true, true>(F.lds + RING_OFF, g, S, E); } SEAM(PH_GA);
#ifndef NO_TOPK
    if (IN(PH_TOPK)) for (int rep_ = 0; rep_ < REP[PH_TOPK]; ++rep_) { dsa::topk_phase((const bf16*)(ws + WS_IDXP), F.in[I_GK], (float*)(ws + WS_SCORES), (unsigned short*)(ws + WS_SEL), (bf16*)(ws + WS_KDN), F.lds + RING_OFF, F.vcu, F.G); }
#endif
    SEAM(PH_TOPK);
    if (IN(PH_GB)) for (int rep_ = 0; rep_ < REP[PH_GB]; ++rep_) { pg8::Gemm g{XN, (const bf16*)(ws + WS_WB), M, NB, D}; pg8::StaticOrder S; S.init(M, NB, F.G, (int)blockIdx.x);
        pg8::EpiProjB E{(bf16*)(ws + WS_P2), (bf16*)(ws + WS_GATES), F.in[I_BGATE]}; pg8::gemm_phase<pg8::EpiProjB, pg8::StaticOrder, true, true>(F.lds + RING_OFF, g, S, E); } SEAM(PH_GB);
    if (IN(PH_ATT)) for (int rep_ = 0; rep_ < REP[PH_ATT]; ++rep_) { for (int r2_ = 0; r2_ < REP_SB; ++r2_) { sba::sb_phase((const bf16*)(ws + WS_P2), (bf16*)(ws + WS_YSB), F.lds + RING_OFF, F.vcu, F.G); __syncthreads(); }
#ifndef NO_DSAATT
        for (int r3_ = 0; r3_ < REP_DSA; ++r3_) dsa::dsa_att_phase((const bf16*)(ws + WS_P2), (const bf16*)(ws + WS_IDXP), (const bf16*)(ws + WS_KDN), (const unsigned short*)(ws + WS_SEL), F.in[I_GQ], (bf16*)(ws + WS_YD), F.lds + RING_OFF, F.vcu, F.G);
#endif
        __syncthreads();
    } SEAM(PH_ATT);
    if (IN(PH_PSB)) for (int rep_ = 0; rep_ < REP[PH_PSB]; ++rep_) { pg8::Gemm g{(const bf16*)(ws + WS_YSB), (const bf16*)(ws + WS_WPSB), M, D, 512}; pg8::StaticOrder S; S.init(M, D, F.G, (int)blockIdx.x);
        pg8::EpiGate1 E{(const bf16*)(ws + WS_GATES), (float*)(ws + WS_TMP)}; pg8::gemm_phase<pg8::EpiGate1, pg8::StaticOrder, true, true>(F.lds + RING_OFF, g, S, E); }
    if (IN(PH_PSB) && IN(PH_PD)) { VM_WAIT(); __syncthreads(); }
    if (IN(PH_PD)) for (int rep_ = 0; rep_ < REP[PH_PD]; ++rep_) { pg8::Gemm g{(const bf16*)(ws + WS_YD), (const bf16*)(ws + WS_WPD), M, D, 512}; pg8::StaticOrder S; S.init(M, D, F.G, (int)blockIdx.x);
        pg8::EpiGate2 E{(const bf16*)(ws + WS_GATES), (const float*)(ws + WS_TMP), (bf16*)(ws + WS_MG)}; pg8::gemm_phase<pg8::EpiGate2, pg8::StaticOrder, true, true>(F.lds + RING_OFF, g, S, E); } SEAM(PH_PD);
    if (IN(PH_WOUT)) { pg8::Gemm g{(const bf16*)(ws + WS_MG), (const bf16*)(ws + WS_WOUT), M, D, D}; pg8::StaticOrder S; S.init(M, D, F.G, (int)blockIdx.x);
        pg8::EpiResid E{F.out, F.out, MOD, 5, 1.0f}; pg8::gemm_phase<pg8::EpiResid, pg8::StaticOrder, true, true>(F.lds + RING_OFF, g, S, E); } SEAM(PH_WOUT);
    if (IN(PH_NORM3)) for (int rep_ = 0; rep_ < REP[PH_NORM3]; ++rep_) { norm_phase(F, F.out, F.in[I_GFFN2], 6, 7); } SEAM(PH_NORM3);
    if (IN(PH_UP2)) for (int rep_ = 0; rep_ < REP[PH_UP2]; ++rep_) { pg8::Gemm g{XN, (const bf16*)(ws + WS_W13_2), M, 2 * FF, D}; pg8::StaticOrder S; S.init(M, 2 * FF, F.G, (int)blockIdx.x);
        pg8::EpiSwiglu E{HB, FF}; pg8::gemm_phase<pg8::EpiSwiglu, pg8::StaticOrder, true, true>(F.lds + RING_OFF, g, S, E); } SEAM(PH_UP2);
    if (IN(PH_DOWN2)) { pg8::Gemm g{HB, (const bf16*)(ws + WS_W2_2), M, D, FF}; pg8::StaticOrder S; S.init(M, D, F.G, (int)blockIdx.x);
        pg8::EpiResid E{F.out, F.out, MOD, 8, 0.5f}; pg8::gemm_phase<pg8::EpiResid, pg8::StaticOrder, true, true>(F.lds + RING_OFF, g, S, E); }
#undef IN
#undef SEAM
}

extern "C" void kernel_launch(void* const* d_in, const int* in_sizes, int n_in, void* d_out, int out_size, void* d_ws, size_t ws_size, hipStream_t stream) {
    static int grid = 0;
    if (grid == 0) {
        if (n_in != 21 || out_size != M * D || ws_size < WS_END) { fprintf(stderr, "kernel_launch: unexpected shapes (n_in %d out %d ws %zu)\n", n_in, out_size, ws_size); grid = -1; return; }
        int dev = 0, cus = 0, per_cu = 0;
        if (hipGetDevice(&dev) != hipSuccess || hipDeviceGetAttribute(&cus, hipDeviceAttributeMultiprocessorCount, dev) != hipSuccess) { grid = -1; return; }
        if (hipFuncSetAttribute((const void*)mk_fwd, hipFuncAttributeMaxDynamicSharedMemorySize, LDS_BYTES) != hipSuccess) { fprintf(stderr, "kernel_launch: hipFuncSetAttribute failed\n"); grid = -1; return; }
        if (hipOccupancyMaxActiveBlocksPerMultiprocessor(&per_cu, (const void*)mk_fwd, NWAVES * 64, LDS_BYTES) != hipSuccess || per_cu < 1) fprintf(stderr, "kernel_launch: occupancy query says %d\n", per_cu);
        (void)hipGetLastError();
        grid = cus;
    }
    if (grid < 0) return;
    (void)hipMemsetAsync((char*)d_ws + WS_CTL, 0, CTL_ZERO_BYTES, stream);
    Args a{};
    for (int i = 0; i < 21; ++i) a.in[i] = (const float*)d_in[i];
    a.out = (float*)d_out; a.ws = (unsigned char*)d_ws;
    unsigned char* ws = (unsigned char*)d_ws;
    int region = 0;
    auto run = [&](int lo, int hi) { a.ph_lo = lo; a.ph_hi = hi; a.region = region++; hipLaunchKernelGGL(mk_fwd, dim3(grid), dim3(NWAVES * 64), LDS_BYTES, stream, a); };
    run(PH_PRO, PH_N);
}
```
